# Optimizing an MI355X kernel written in HIP

```python
import jax, jax.numpy as jnp
from jax import lax
import numpy as np

D_MODEL = 1024
BATCH = 32
SEQ = 256
DEPTH = 1
DEC_BATCH = 8
DEC_SEQ = 4096
PAST_LEN = 512

GRID_W = 64
N_FOUR_GROUPS = 4
FOUR_GROUP = 128
FOUR_W = N_FOUR_GROUPS * FOUR_GROUP
N_HEADS = 4
HEAD_K = 128
HEAD_V = 128
HGRN_K_W = N_HEADS * HEAD_K
HGRN_V_W = N_HEADS * HEAD_V
D_FF = 2816
CHUNK = 32
N_MOD = 9
EPS = 1e-6
IN_COLS = FOUR_W + 3 * HGRN_K_W + 2 * HGRN_V_W + 2 * D_MODEL

kernel_name = "hybrid_fnet_hgrn2_macaron_diffusion_step"


def rms_norm(x, gain):
    xf = x.astype(jnp.float32)
    y = xf * lax.rsqrt(jnp.mean(xf * xf, axis=-1, keepdims=True) + EPS)
    return (y * gain.astype(jnp.float32)).astype(x.dtype)


def swiglu(h, w_in, w_out):
    g, u = jnp.split(h @ w_in, 2, axis=-1)
    return (jax.nn.silu(g) * u) @ w_out


def fourier_mix(u, rows):
    B, L, _ = u.shape
    uf = u.astype(jnp.float32)
    if rows is None:
        uf = uf.reshape(B, L, N_FOUR_GROUPS, FOUR_GROUP)
        y = jnp.fft.fftn(uf, axes=(1, 3), norm="ortho").real
    else:
        uf = uf.reshape(B, rows, GRID_W, N_FOUR_GROUPS, FOUR_GROUP)
        y = jnp.fft.fftn(uf, axes=(1, 2, 4), norm="ortho").real
    return y.reshape(B, L, FOUR_W).astype(u.dtype)


def _to_chunks(a):
    B, L, H, E = a.shape
    return a.reshape(B, L // CHUNK, CHUNK, H, E).transpose(1, 0, 3, 2, 4)


def hgrn2_scan(q, f, v, s0):
    B, L, H, _ = q.shape
    log_f = jnp.log(f)
    k = 1.0 - f
    tril = jnp.tril(jnp.ones((CHUNK, CHUNK), dtype=bool))[:, :, None]

    def step(S, inp):
        qc, lfc, kc, vc = inp
        b = jnp.cumsum(lfc, axis=2)
        diff = b[:, :, :, None, :] - b[:, :, None, :, :]
        decay = jnp.where(tril, jnp.exp(jnp.where(tril, diff, 0.0)), 0.0)
        A = jnp.sum(qc[:, :, :, None, :] * kc[:, :, None, :, :] * decay, axis=-1)
        o = (jnp.einsum('bhts,bhsv->bhtv', A, vc)
             + jnp.einsum('bhtk,bhkv->bhtv', qc * jnp.exp(b), S))
        b_last = b[:, :, -1:, :]
        S = (jnp.exp(b_last[:, :, 0, :])[..., None] * S
             + jnp.einsum('bhsk,bhsv->bhkv', kc * jnp.exp(b_last - b), vc))
        return S, o

    s_final, o = lax.scan(step, s0, (_to_chunks(q), _to_chunks(log_f), _to_chunks(k), _to_chunks(v)))
    o = o.transpose(1, 0, 3, 2, 4).reshape(B, L, H, v.shape[-1])
    return o, s_final


def mixer(h, w_in, w_four, hgrn_gain, w_hgrn, w_out, lb, s0_f, s0_b, rows):
    B, L, _ = h.shape
    splits = [int(s) for s in np.cumsum([FOUR_W, HGRN_K_W, HGRN_K_W, HGRN_K_W, HGRN_V_W, HGRN_V_W, D_MODEL])]
    u, q, zf, zb, i, g, ga, gb = jnp.split(h @ w_in, splits, axis=-1)
    branch_a = fourier_mix(u, rows) @ w_four
    qh = jax.nn.silu(q.astype(jnp.float32)).reshape(B, L, N_HEADS, HEAD_K)
    vh = i.astype(jnp.float32).reshape(B, L, N_HEADS, HEAD_V)
    f_f = (lb[0] + (1.0 - lb[0]) * jax.nn.sigmoid(zf.astype(jnp.float32))).reshape(B, L, N_HEADS, HEAD_K)
    f_b = (lb[1] + (1.0 - lb[1]) * jax.nn.sigmoid(zb.astype(jnp.float32))).reshape(B, L, N_HEADS, HEAD_K)
    o_f, s_f = hgrn2_scan(qh, f_f, vh, s0_f)
    o_b, s_b = hgrn2_scan(jnp.flip(qh, 1), jnp.flip(f_b, 1), jnp.flip(vh, 1), s0_b)
    o = o_f + jnp.flip(o_b, 1)
    o = o * lax.rsqrt(jnp.mean(o * o, axis=-1, keepdims=True) + EPS)
    o = o.reshape(B, L, HGRN_V_W) * hgrn_gain.astype(jnp.float32) * jax.nn.silu(g.astype(jnp.float32))
    branch_b = o.astype(h.dtype) @ w_hgrn
    merged = jax.nn.sigmoid(ga) * branch_a + jax.nn.sigmoid(gb) * branch_b
    return merged @ w_out, s_f, s_b


def trunk_layer(x, cond, w_mod, b_mod, norm_pre, norm_post, ffn_w_in, ffn_w_out,
                w_in, w_four, hgrn_gain, w_hgrn, w_out, lb, s0_f, s0_b, rows):
    mod = (jax.nn.silu(cond) @ w_mod + b_mod)[:, None, :]
    sh1, sc1, g1, sh2, sc2, g2, sh3, sc3, g3 = jnp.split(mod, N_MOD, axis=-1)
    h = rms_norm(x, norm_pre[0]) * (1.0 + sc1) + sh1
    x = x + 0.5 * g1 * rms_norm(swiglu(h, ffn_w_in[0], ffn_w_out[0]), norm_post[0])
    h = rms_norm(x, norm_pre[1]) * (1.0 + sc2) + sh2
    m, s_f, s_b = mixer(h, w_in, w_four, hgrn_gain, w_hgrn, w_out, lb, s0_f, s0_b, rows)
    x = x + g2 * rms_norm(m, norm_post[1])
    h = rms_norm(x, norm_pre[2]) * (1.0 + sc3) + sh3
    x = x + 0.5 * g3 * rms_norm(swiglu(h, ffn_w_in[1], ffn_w_out[1]), norm_post[2])
    return x, s_f, s_b


def setup_inputs(seed: int = 0) -> dict:
    key = jax.random.key(seed)
    ks = jax.random.split(key, 17)
    n = jax.random.normal
    f32 = jnp.float32
    return {
        "x_prompt": n(ks[0], (BATCH, SEQ, D_MODEL), f32),
        "x_sample": n(ks[1], (DEC_BATCH, DEC_SEQ, D_MODEL), f32),
        "state_hgrn": 0.5 * n(ks[2], (DEC_BATCH, DEPTH, 2, N_HEADS, HEAD_K, HEAD_V), f32),
        "c": n(ks[3], (DEC_BATCH, D_MODEL), f32),
        "c_ctx": n(ks[4], (D_MODEL,), f32),
        "w_mod": 0.5 * D_MODEL ** -0.5 * n(ks[5], (DEPTH, D_MODEL, N_MOD * D_MODEL), f32),
        "b_mod": 0.01 * n(ks[6], (DEPTH, N_MOD * D_MODEL), f32),
        "norm_pre": 1.0 + 0.05 * n(ks[7], (DEPTH, 3, D_MODEL), f32),
        "norm_post": 1.0 + 0.05 * n(ks[8], (DEPTH, 3, D_MODEL), f32),
        "ffn_w_in": D_MODEL ** -0.5 * n(ks[9], (DEPTH, 2, D_MODEL, 2 * D_FF), f32),
        "ffn_w_out": D_FF ** -0.5 * n(ks[10], (DEPTH, 2, D_FF, D_MODEL), f32),
        "w_in": D_MODEL ** -0.5 * n(ks[11], (DEPTH, D_MODEL, IN_COLS), f32),
        "w_four": FOUR_W ** -0.5 * n(ks[12], (DEPTH, FOUR_W, D_MODEL), f32),
        "hgrn_gain": 1.0 + 0.05 * n(ks[13], (DEPTH, HGRN_V_W), f32),
        "w_hgrn": HGRN_V_W ** -0.5 * n(ks[14], (DEPTH, HGRN_V_W, D_MODEL), f32),
        "w_out": D_MODEL ** -0.5 * n(ks[15], (DEPTH, D_MODEL, D_MODEL), f32),
        "lb_logits": 0.5 * n(ks[16], (DEPTH + 1, 2, HGRN_K_W), f32),
    }


def reference(x_prompt, x_sample, state_hgrn, c, c_ctx, w_mod, b_mod, norm_pre, norm_post,
              ffn_w_in, ffn_w_out, w_in, w_four, hgrn_gain, w_hgrn, w_out, lb_logits):
    lb_all = jnp.cumsum(jax.nn.softmax(lb_logits.astype(jnp.float32), axis=0), axis=0)
    rows = x_sample.shape[1] // GRID_W

    y_prompt = x_prompt
    zero_state = jnp.zeros((x_prompt.shape[0], N_HEADS, HEAD_K, HEAD_V), jnp.float32)
    layer_states = []
    for l in range(DEPTH):
        y_prompt, s_f, s_b = trunk_layer(
            y_prompt, c_ctx[None, :], w_mod[l], b_mod[l], norm_pre[l], norm_post[l],
            ffn_w_in[l], ffn_w_out[l], w_in[l], w_four[l], hgrn_gain[l], w_hgrn[l], w_out[l],
            lb_all[l], zero_state, zero_state, None)
        layer_states.append(jnp.stack([s_f, s_b], axis=1))
    new_state_hgrn = jnp.stack(layer_states, axis=1).astype(x_prompt.dtype)

    y_sample = x_sample
    for l in range(DEPTH):
        y_sample, _, _ = trunk_layer(
            y_sample, c, w_mod[l], b_mod[l], norm_pre[l], norm_post[l],
            ffn_w_in[l], ffn_w_out[l], w_in[l], w_four[l], hgrn_gain[l], w_hgrn[l], w_out[l],
            lb_all[l], state_hgrn[:, l, 0].astype(jnp.float32), state_hgrn[:, l, 1].astype(jnp.float32), rows)

    return (y_prompt, y_sample, new_state_hgrn)
```

```cpp
#include <hip/hip_runtime.h>
#include <hip/hip_cooperative_groups.h>
#include <cstdio>
namespace cg = cooperative_groups;

#define LAS __attribute__((address_space(3)))
typedef unsigned short bf16_t;
typedef short bf16x8 __attribute__((ext_vector_type(8)));
typedef float f32x4 __attribute__((ext_vector_type(4)));
typedef unsigned u32x4 __attribute__((ext_vector_type(4)));
typedef unsigned u32x2 __attribute__((ext_vector_type(2)));

constexpr int T_ALL = 40960, T_CTX = 8192, DM = 1024, DFF = 2816;
constexpr float EPS = 1e-6f;
constexpr int LDS_PHASE_BYTES = 131072;
constexpr int LDS_BYTES = LDS_PHASE_BYTES + 16;
constexpr int NPHASE = 17;
constexpr int FFN_KSPLIT = 1;

constexpr size_t WS_WIN0 = 0;
constexpr size_t WS_WIN1 = WS_WIN0 + (size_t)5632 * 1024 * 2;
constexpr size_t WS_WOUT0 = WS_WIN1 + (size_t)5632 * 1024 * 2;
constexpr size_t WS_WOUT1 = WS_WOUT0 + (size_t)1024 * 2816 * 2;
constexpr size_t WS_WMIXA = WS_WOUT1 + (size_t)1024 * 2816 * 2;
constexpr size_t WS_WGATE = WS_WMIXA + (size_t)3584 * 1024 * 2;
constexpr size_t WS_WFOUR = WS_WGATE + (size_t)2048 * 1024 * 2;
constexpr size_t WS_WHGRN = WS_WFOUR + (size_t)1024 * 1024 * 2;
constexpr size_t WS_WO = WS_WHGRN + (size_t)1024 * 512 * 2;
constexpr size_t WS_TTC = WS_WO + (size_t)1024 * 1024 * 2;
constexpr size_t WS_TT2 = WS_TTC + (size_t)256 * 512 * 2;
constexpr size_t WS_TT3 = WS_TT2 + (size_t)128 * 128 * 2;
constexpr size_t WS_MOD = WS_TT3 + (size_t)64 * 128 * 2;
constexpr size_t WS_LB = WS_MOD + (size_t)9 * 9216 * 4;
constexpr size_t WS_DB = WS_LB + (size_t)1024 * 4;
constexpr size_t WS_BAR = WS_DB + (size_t)64 * 16 * 128 * 4;
constexpr size_t WS_HF = WS_BAR + 16384;
constexpr size_t WS_R = WS_HF + (size_t)T_ALL * 1024 * 2;
constexpr size_t R_PZ = 0;
constexpr size_t R_PQ = R_PZ + (size_t)T_ALL * 1024 * 2;
constexpr size_t R_LFF = R_PQ + (size_t)T_ALL * 512 * 2;
constexpr size_t R_LFB = R_LFF + (size_t)T_ALL * 512 * 2;
constexpr size_t R_PV = R_LFB + (size_t)T_ALL * 512 * 2;
constexpr size_t R_SG = R_PV + (size_t)T_ALL * 512 * 2;
constexpr size_t R_END = R_SG + (size_t)T_ALL * 512 * 2;
constexpr size_t R_GA = R_LFF;
constexpr size_t R_GB = R_GA + (size_t)T_ALL * 1024 * 2;
constexpr size_t WS_S = WS_R + R_END;
constexpr size_t WS_STASH = WS_S + (size_t)64 * 16 * 16384 * 4;
constexpr size_t WS_END = WS_STASH + (size_t)256 * 32768 * 4;

struct Params {
    const float* in[17];
    float* out;
    unsigned char* ws;
    int pad0, pad1;
};

typedef __bf16 bf16v2_t __attribute__((ext_vector_type(2)));
typedef float f32x2_t __attribute__((ext_vector_type(2)));
__device__ __forceinline__ unsigned cvt_pk_bf16(float lo, float hi) { const f32x2_t v = {lo, hi}; const bf16v2_t b = __builtin_convertvector(v, bf16v2_t); return __builtin_bit_cast(unsigned, b); }
__device__ __forceinline__ bf16_t f2bf(float f) { return (bf16_t)(cvt_pk_bf16(f, 0.f) & 0xffffu); }
__device__ __forceinline__ float bflo(unsigned w) { return __uint_as_float(w << 16); }
__device__ __forceinline__ float bfhi(unsigned w) { return __uint_as_float(w & 0xffff0000u); }
__device__ __forceinline__ float silu_f(float x) { return x * __builtin_amdgcn_rcpf(1.f + __builtin_amdgcn_exp2f(-1.44269504089f * x)); }
__device__ __forceinline__ float sigm_f(float x) { return __builtin_amdgcn_rcpf(1.f + __builtin_amdgcn_exp2f(-1.44269504089f * x)); }
__device__ __forceinline__ float wave_sum(float v) {
#pragma unroll
    for (int o = 32; o > 0; o >>= 1) v += __shfl_xor(v, o);
    return v;
}


#define XB_TMO      128
#define XB_XCNT(j)  (256  + 64 * (j))
#define XB_XSUB(j)  (1280 + 64 * (j))
#define XB_XGEN(j)  (2304 + 64 * (j))
#define XB_TOP      3328
#define XB_TOPGEN   3392
#define XCD_BAR_WORDS 3456
#define XB_SPIN_CAP (1u << 18)
__device__ __forceinline__ unsigned xb_ld(unsigned* p)              { return __hip_atomic_load(p, __ATOMIC_RELAXED, __HIP_MEMORY_SCOPE_AGENT); }
__device__ __forceinline__ unsigned xb_add(unsigned* p, unsigned v) { return __hip_atomic_fetch_add(p, v, __ATOMIC_RELAXED, __HIP_MEMORY_SCOPE_AGENT); }
__device__ __forceinline__ unsigned xb_xcc_id() { return (unsigned)__builtin_amdgcn_s_getreg((3 << 11) | 20) & 0xFu; }
#define XB_SPIN(cond, bar) do { unsigned _sp = 0; while (cond) { __builtin_amdgcn_s_sleep(6); \
    if ((++_sp & 255u) == 0u) { if (xb_ld(&(bar)[XB_TMO])) break; if (_sp > XB_SPIN_CAP) { atomicAdd(&(bar)[XB_TMO], 1u); break; } } } } while (0)
struct XcdBarrier { unsigned* bar; unsigned x; volatile LAS unsigned* st; };
__device__ __forceinline__ XcdBarrier xcd_barrier_post(unsigned* bar, volatile LAS unsigned* st) {
    XcdBarrier b; b.bar = bar; b.x = xb_xcc_id(); b.st = st;
    if (threadIdx.x == 0) (void)xb_add(&bar[XB_XCNT(b.x)], 1u);
    return b;
}
__device__ __forceinline__ void xcd_barrier_complete(unsigned* bar, unsigned x, unsigned& nloc, unsigned& nx) {
    const unsigned G = gridDim.x * gridDim.y * gridDim.z;
    unsigned sum, cnt, mine, sp = 0u;
    for (;;) {
        sum = 0u; cnt = 0u; mine = 0u;
#pragma unroll
        for (unsigned j = 0; j < 16; ++j) { const unsigned c = xb_ld(&bar[XB_XCNT(j)]); sum += c; cnt += (c > 0u) ? 1u : 0u; mine = (j == x) ? c : mine; }
        if (sum == G) break;
        __builtin_amdgcn_s_sleep(1);
        if ((++sp & 255u) == 0u) { if (xb_ld(&bar[XB_TMO])) break; if (sp > XB_SPIN_CAP) { atomicAdd(&bar[XB_TMO], 1u); break; } }
    }
    nloc = mine > 0u ? mine : 1u; nx = cnt > 0u ? cnt : 1u;
}
__device__ __forceinline__ void xcd_barrier(const XcdBarrier& b) {
    asm volatile("s_waitcnt vmcnt(0)" ::: "memory");
    __syncthreads();
    if (threadIdx.x == 0) {
        unsigned* bar = b.bar;
        __builtin_amdgcn_s_waitcnt(0);
        unsigned nloc = b.st[0], nx = b.st[1];
        if (nloc == 0u) { xcd_barrier_complete(bar, b.x, nloc, nx); b.st[0] = nloc; b.st[1] = nx; }
        const unsigned old = xb_add(&bar[XB_XSUB(b.x)], 1u);
        const unsigned gen = old / nloc;
        if (old + 1u == (gen + 1u) * nloc) {
            __builtin_amdgcn_fence(__ATOMIC_RELEASE, "agent");
            asm volatile("s_waitcnt vmcnt(0)" ::: "memory");
            const unsigned og = xb_add(&bar[XB_TOP], 1u);
            const unsigned tg = og / nx;
            if (og + 1u == (tg + 1u) * nx) xb_add(&bar[XB_TOPGEN], 1u);
            else XB_SPIN(xb_ld(&bar[XB_TOPGEN]) == tg, bar);
            __builtin_amdgcn_fence(__ATOMIC_ACQUIRE, "agent");
            xb_add(&bar[XB_XGEN(b.x)], 1u);
            asm volatile("s_waitcnt vmcnt(0)" ::: "memory");
        } else {
            XB_SPIN(xb_ld(&bar[XB_XGEN(b.x)]) == gen, bar);
            __builtin_amdgcn_fence(__ATOMIC_ACQUIRE, "agent");
            asm volatile("s_waitcnt vmcnt(0)" ::: "memory");
        }
    }
    __syncthreads();
}

namespace pg8 {
constexpr int BM = 256, BK = 64, HALF = 128, HTB = HALF * BK * 2, STAGE_BYTES = 8 * HTB, NXCD = 8, WGM = 8;
__device__ __forceinline__ int lds_byte(int r, int c) { const int st = (r >> 4) * 2 + (c >> 5), rr = r & 15, cc = c & 31, ob = rr * 64 + cc * 2; return st * 1024 + (ob ^ (((ob >> 9) & 1) << 5)); }
__device__ __forceinline__ void stage_rc(int b, int& R, int& C) { const int st = b / 1024, sb = b % 1024, swz = sb ^ (((sb >> 9) & 1) << 5); R = (st >> 1) * 16 + swz / 64; C = (st & 1) * 32 + (swz % 64) / 2; }
__device__ __forceinline__ int perm32(int rho) { const int n = rho >> 4, i = rho & 15; return 8 * (i >> 2) + 4 * n + (i & 3); }
struct Unit { int pm, pn, ks; };
struct Gemm { const bf16_t* A; const bf16_t* Bt; int M, N, K, lda, ldb, eva; };
struct StaticOrder {
    int nM, nN, nwg, nall, G, c;
    __device__ void init(int M, int N, int KS, int G_, int c_) { nM = M / BM; nN = N / BM; nwg = nM * nN; nall = nwg * KS; G = G_; c = c_; }
    __device__ bool next(int i, Unit& u) const {
        const long L = (long)i * G + c; if (L >= nall) return false;
        u.ks = (int)(L / nwg);
        int wgid = (int)(L % nwg); { const int q = nwg / NXCD, r = nwg % NXCD, xcd = wgid % NXCD, off = wgid / NXCD; wgid = (xcd < r ? xcd * (q + 1) : r * (q + 1) + (xcd - r) * q) + off; }
        const int nig = WGM * nN, gid = wgid / nig, fm = gid * WGM, gsz = (nM - fm) < WGM ? (nM - fm) : WGM;
        u.pm = fm + ((wgid % nig) % gsz); u.pn = (wgid % nig) / gsz; return true;
    }
};

template <class Epi>
__device__ __forceinline__ void gemm_phase(LAS unsigned char* lds, const Gemm g, const StaticOrder& S, const Epi& E) {
    const int tid = threadIdx.x, wid = __builtin_amdgcn_readfirstlane(tid >> 6), lane = tid & 63, wr = wid >> 2, wc = wid & 3, fr = lane & 15, fq = lane >> 4;
    const int K = g.K, nt = K / BK;
    unsigned voffA[2], voffB[2];
#pragma unroll
    for (int i = 0; i < 2; ++i) { int R, C; stage_rc(tid * 16 + i * 8192, R, C); const int Rb = (R & ~31) + perm32(R & 31);
        voffA[i] = (unsigned)(R * g.lda + C) * 2u; voffB[i] = (unsigned)(Rb * g.ldb + C) * 2u; }
    const size_t kstep = (size_t)(BK * 2);
    const size_t hstepA = (size_t)HALF * g.lda * 2, hstepB = (size_t)HALF * g.ldb * 2;
    const size_t tstepA = 2 * hstepA, tstepB = 2 * hstepB;
    const size_t eva = (size_t)g.eva, ksoffA = (size_t)(K / 128) * eva, ksoffB = (size_t)K * 2;
    const unsigned ldsw = (unsigned)wid * 1024u;
    const int aoff = lds_byte(wr * 64 + fr, fq * 8), boff = lds_byte(wc * 32 + fr, fq * 8);
#define PG8_SA(b, h) (((b) * 2 + (h)) * HTB)
#define PG8_SB(b, h) ((4 + (b) * 2 + (h)) * HTB)
#define PG8_STAGE(bufoff, gbase, voff) do { _Pragma("unroll") for (int _i = 0; _i < 2; ++_i) \
        __builtin_amdgcn_global_load_lds((const unsigned*)((const char*)(gbase) + (voff)[_i]), (LAS unsigned*)(lds + (bufoff) + ldsw + _i * 8192), 16, 0, 0); } while (0)
#define PG8_LDA(dst, b, h) do { _Pragma("unroll") for (int m = 0; m < 4; ++m) _Pragma("unroll") for (int k = 0; k < 2; ++k) dst[m][k] = *(const LAS bf16x8*)(lds + PG8_SA(b, h) + aoff + m * 2048 + k * 1024); } while (0)
#define PG8_LDB(dst, b, h) do { _Pragma("unroll") for (int n = 0; n < 2; ++n) _Pragma("unroll") for (int k = 0; k < 2; ++k) dst[n][k] = *(const LAS bf16x8*)(lds + PG8_SB(b, h) + boff + n * 2048 + k * 1024); } while (0)
#define PG8_MMA(ai, bj, At, Bt) do { __builtin_amdgcn_s_setprio(1); _Pragma("unroll") for (int m = 0; m < 4; ++m) _Pragma("unroll") for (int n = 0; n < 2; ++n) _Pragma("unroll") for (int k = 0; k < 2; ++k) \
        acc[ai][bj][m][n] = __builtin_amdgcn_mfma_f32_16x16x32_bf16(Bt[n][k], At[m][k], acc[ai][bj][m][n], 0, 0, 0); __builtin_amdgcn_s_setprio(0); } while (0)
#define PG8_WAIT_V(n) asm volatile("s_waitcnt vmcnt(" #n ")" ::: "memory")
#define PG8_WAIT_L(n) asm volatile("s_waitcnt lgkmcnt(" #n ")" ::: "memory")
#define PG8_BAR __builtin_amdgcn_s_barrier()
#define PG8_SCHED __builtin_amdgcn_sched_barrier(0)
    Unit cur, nxt; int ui = 0;
    if (!S.next(0, cur)) return;
    f32x4 acc[2][2][4][2];
#pragma unroll
    for (int a = 0; a < 2; ++a)
#pragma unroll
        for (int b = 0; b < 2; ++b)
#pragma unroll
            for (int m = 0; m < 4; ++m)
#pragma unroll
                for (int n = 0; n < 2; ++n) acc[a][b][m][n] = (f32x4){0.f, 0.f, 0.f, 0.f};
    bf16x8 At[4][2], B0[2][2], B1[2][2];
    const char* cA = (const char*)g.A + (size_t)cur.pm * tstepA + (size_t)cur.ks * ksoffA; const char* cB = (const char*)g.Bt + (size_t)cur.pn * tstepB + (size_t)cur.ks * ksoffB;
    PG8_STAGE(PG8_SB(0, 0), cB, voffB); PG8_STAGE(PG8_SA(0, 0), cA, voffA); PG8_STAGE(PG8_SB(0, 1), cB + hstepB, voffB); PG8_STAGE(PG8_SA(0, 1), cA + hstepA, voffA);
    if (wr == 1) PG8_BAR;
    PG8_WAIT_V(4); PG8_BAR;
    PG8_STAGE(PG8_SB(1, 0), cB + kstep, voffB); PG8_STAGE(PG8_SA(1, 0), cA + kstep, voffA); PG8_STAGE(PG8_SB(1, 1), cB + hstepB + kstep, voffB);
    PG8_WAIT_V(6); PG8_BAR;
    for (;;) {
        const bool has_next = S.next(ui + 1, nxt);
        const char* nA = has_next ? (const char*)g.A + (size_t)nxt.pm * tstepA + (size_t)nxt.ks * ksoffA : cA; const char* nB = has_next ? (const char*)g.Bt + (size_t)nxt.pn * tstepB + (size_t)nxt.ks * ksoffB : cB;
        for (int t = 0; t < nt; t += 2) {
            const bool last = (t == nt - 2);
            const char* a1 = cA + (size_t)(t >> 1) * eva + kstep;
            const char* a2 = last ? nA : cA + (size_t)((t >> 1) + 1) * eva; const char* b2 = last ? nB : cB + (size_t)(t + 2) * kstep;
            const char* a3 = a2 + kstep; const char* b3 = b2 + kstep;
            PG8_LDB(B0, 0, 0); PG8_SCHED; PG8_LDA(At, 0, 0); PG8_STAGE(PG8_SA(1, 1), a1 + hstepA, voffA);
            PG8_WAIT_L(8); PG8_BAR; PG8_WAIT_L(0); PG8_MMA(0, 0, At, B0); PG8_BAR; PG8_SCHED;
            PG8_LDB(B1, 0, 1); PG8_STAGE(PG8_SB(0, 0), b2, voffB);
            PG8_BAR; PG8_WAIT_L(0); PG8_MMA(0, 1, At, B1); PG8_BAR;
            PG8_LDA(At, 0, 1); PG8_STAGE(PG8_SA(0, 0), a2, voffA);
            PG8_BAR; PG8_WAIT_L(0); PG8_MMA(1, 0, At, B0); PG8_BAR; PG8_SCHED;
            PG8_STAGE(PG8_SB(0, 1), b2 + hstepB, voffB);
            PG8_WAIT_V(6); PG8_BAR; PG8_MMA(1, 1, At, B1); PG8_BAR;
            PG8_LDB(B0, 1, 0); PG8_SCHED; PG8_LDA(At, 1, 0); PG8_STAGE(PG8_SA(0, 1), a2 + hstepA, voffA);
            PG8_WAIT_L(8); PG8_BAR; PG8_WAIT_L(0); PG8_MMA(0, 0, At, B0); PG8_BAR; PG8_SCHED;
            PG8_LDB(B1, 1, 1); PG8_STAGE(PG8_SB(1, 0), b3, voffB);
            PG8_BAR; PG8_WAIT_L(0); PG8_MMA(0, 1, At, B1); PG8_BAR;
            PG8_LDA(At, 1, 1); PG8_STAGE(PG8_SA(1, 0), a3, voffA);
            PG8_BAR; PG8_WAIT_L(0); PG8_MMA(1, 0, At, B0); PG8_BAR; PG8_SCHED;
            PG8_STAGE(PG8_SB(1, 1), b3 + hstepB, voffB);
            PG8_WAIT_V(6); PG8_BAR; PG8_MMA(1, 1, At, B1); PG8_BAR;
        }
        E(acc, cur, wr, wc, fr, fq);
        if (!has_next) break;
#pragma unroll
        for (int a = 0; a < 2; ++a)
#pragma unroll
            for (int b = 0; b < 2; ++b)
#pragma unroll
                for (int m = 0; m < 4; ++m)
#pragma unroll
                    for (int n = 0; n < 2; ++n) acc[a][b][m][n] = (f32x4){0.f, 0.f, 0.f, 0.f};
        cur = nxt; cA = nA; cB = nB; ++ui;
    }
    PG8_WAIT_V(0);
    if (wr == 0) PG8_BAR;
    PG8_BAR;
#undef PG8_SA
#undef PG8_SB
#undef PG8_STAGE
#undef PG8_LDA
#undef PG8_LDB
#undef PG8_MMA
#undef PG8_WAIT_V
#undef PG8_WAIT_L
#undef PG8_BAR
#undef PG8_SCHED
}
}

typedef f32x4 AccT[2][2][4][2];
__device__ __forceinline__ u32x4 pack8(const f32x4 a, const f32x4 b) { u32x4 w; w.x = cvt_pk_bf16(a[0], a[1]); w.y = cvt_pk_bf16(a[2], a[3]); w.z = cvt_pk_bf16(b[0], b[1]); w.w = cvt_pk_bf16(b[2], b[3]); return w; }

struct EpiPlain {
    bf16_t* O; int ldc; bf16_t* O1 = nullptr;
    __device__ __forceinline__ void operator()(const AccT& acc, const pg8::Unit& u, int wr, int wc, int fr, int fq) const {
        bf16_t* O = u.ks ? this->O1 : this->O;
        const int row0 = u.pm * 256 + wr * 64 + fr, col0 = u.pn * 256 + wc * 32 + 8 * fq;
#pragma unroll
        for (int ai = 0; ai < 2; ++ai)
#pragma unroll
            for (int m = 0; m < 4; ++m) { bf16_t* rowp = O + (size_t)(row0 + ai * 128 + m * 16) * ldc + col0;
#pragma unroll
                for (int bj = 0; bj < 2; ++bj) *(u32x4*)(rowp + bj * 128) = pack8(acc[ai][bj][m][0], acc[ai][bj][m][1]); }
    }
};
struct EpiSwiglu {
    bf16_t* O;
    __device__ __forceinline__ void operator()(const AccT& acc, const pg8::Unit& u, int wr, int wc, int fr, int fq) const {
        const int row0 = u.pm * 256 + wr * 64 + fr, col0 = u.pn * 128 + wc * 32 + 8 * fq;
#pragma unroll
        for (int ai = 0; ai < 2; ++ai)
#pragma unroll
            for (int m = 0; m < 4; ++m) {
                f32x4 o0, o1;
#pragma unroll
                for (int j = 0; j < 4; ++j) { o0[j] = silu_f(acc[ai][0][m][0][j]) * acc[ai][1][m][0][j]; o1[j] = silu_f(acc[ai][0][m][1][j]) * acc[ai][1][m][1][j]; }
                *(u32x4*)(O + (size_t)(row0 + ai * 128 + m * 16) * DFF + col0) = pack8(o0, o1);
            }
    }
};
struct EpiMixA {
    bf16_t *PZ, *Pq, *Plff, *Plfb, *Pv, *Psg; const float* lb;
    __device__ __forceinline__ void operator()(const AccT& acc, const pg8::Unit& u, int wr, int wc, int fr, int fq) const {
        const int pn = u.pn; bf16_t* base; int ldc, colt, mode; const float* lbp = lb;
        if (pn < 4) { base = PZ; ldc = 1024; colt = pn * 256; mode = 0; }
        else { const int s = (pn - 4) >> 1; colt = ((pn - 4) & 1) * 256; ldc = 512;
            if (s == 0) { base = Pq; mode = 1; } else if (s == 1) { base = Plff; mode = 2; } else if (s == 2) { base = Plfb; mode = 2; lbp = lb + 512; } else if (s == 3) { base = Pv; mode = 0; } else { base = Psg; mode = 1; } }
        const int row0 = u.pm * 256 + wr * 64 + fr, col0 = colt + wc * 32 + 8 * fq;
        f32x4 lbv[2][2];
#pragma unroll
        for (int bj = 0; bj < 2; ++bj) { lbv[bj][0] = (f32x4){0.f, 0.f, 0.f, 0.f}; lbv[bj][1] = lbv[bj][0];
            if (mode == 2) { lbv[bj][0] = *(const f32x4*)(lbp + col0 + bj * 128); lbv[bj][1] = *(const f32x4*)(lbp + col0 + bj * 128 + 4); } }
#pragma unroll
        for (int ai = 0; ai < 2; ++ai)
#pragma unroll
            for (int m = 0; m < 4; ++m) { bf16_t* rowp = base + (size_t)(row0 + ai * 128 + m * 16) * ldc + col0;
#pragma unroll
                for (int bj = 0; bj < 2; ++bj) { f32x4 v0 = acc[ai][bj][m][0], v1 = acc[ai][bj][m][1];
                    if (mode == 1) {
#pragma unroll
                        for (int j = 0; j < 4; ++j) { v0[j] = silu_f(v0[j]); v1[j] = silu_f(v1[j]); } }
                    else if (mode == 2) {
#pragma unroll
                        for (int j = 0; j < 4; ++j) { const float l0 = lbv[bj][0][j], l1 = lbv[bj][1][j];
                            v0[j] = __logf(l0 + (1.f - l0) * sigm_f(v0[j])); v1[j] = __logf(l1 + (1.f - l1) * sigm_f(v1[j])); } }
                    *(u32x4*)(rowp + bj * 128) = pack8(v0, v1); } }
    }
};
struct EpiGate {
    bf16_t *Ga, *Gb;
    __device__ __forceinline__ void operator()(const AccT& acc, const pg8::Unit& u, int wr, int wc, int fr, int fq) const {
        bf16_t* base = u.pn < 4 ? Ga : Gb;
        const int row0 = u.pm * 256 + wr * 64 + fr, col0 = (u.pn & 3) * 256 + wc * 32 + 8 * fq;
#pragma unroll
        for (int ai = 0; ai < 2; ++ai)
#pragma unroll
            for (int m = 0; m < 4; ++m) { bf16_t* rowp = base + (size_t)(row0 + ai * 128 + m * 16) * 1024 + col0;
#pragma unroll
                for (int bj = 0; bj < 2; ++bj) { f32x4 v0 = acc[ai][bj][m][0], v1 = acc[ai][bj][m][1];
#pragma unroll
                    for (int j = 0; j < 4; ++j) { v0[j] = sigm_f(v0[j]); v1[j] = sigm_f(v1[j]); }
                    *(u32x4*)(rowp + bj * 128) = pack8(v0, v1); } }
    }
};
struct EpiGateMerge {
    const bf16_t *BA, *BB; bf16_t* O;
    __device__ __forceinline__ void operator()(const AccT& acc, const pg8::Unit& u, int wr, int wc, int fr, int fq) const {
        const int row0 = u.pm * 256 + wr * 64 + fr, col0 = u.pn * 128 + wc * 32 + 8 * fq;
#pragma unroll
        for (int ai = 0; ai < 2; ++ai) {
            u32x4 pa[4], pb[4];
#pragma unroll
            for (int m = 0; m < 4; ++m) { const size_t ro = (size_t)(row0 + ai * 128 + m * 16) * 1024 + col0;
                pa[m] = *(const u32x4*)(BA + ro); pb[m] = *(const u32x4*)(BB + ro); }
#pragma unroll
            for (int m = 0; m < 4; ++m) { const size_t ro = (size_t)(row0 + ai * 128 + m * 16) * 1024 + col0;
                const u32x4 a = pa[m], b = pb[m];
                const f32x4 a0 = (f32x4){bflo(a.x), bfhi(a.x), bflo(a.y), bfhi(a.y)}, a1 = (f32x4){bflo(a.z), bfhi(a.z), bflo(a.w), bfhi(a.w)};
                const f32x4 b0 = (f32x4){bflo(b.x), bfhi(b.x), bflo(b.y), bfhi(b.y)}, b1 = (f32x4){bflo(b.z), bfhi(b.z), bflo(b.w), bfhi(b.w)};
                f32x4 o0, o1;
#pragma unroll
                for (int j = 0; j < 4; ++j) { o0[j] = sigm_f(acc[ai][0][m][0][j]) * a0[j] + sigm_f(acc[ai][1][m][0][j]) * b0[j];
                    o1[j] = sigm_f(acc[ai][0][m][1][j]) * a1[j] + sigm_f(acc[ai][1][m][1][j]) * b1[j]; }
                *(u32x4*)(O + ro) = pack8(o0, o1); }
        }
    }
};
template <int MODE> struct EpiMerge {
    bf16_t *Ga; const bf16_t* Gb;
    __device__ __forceinline__ void operator()(const AccT& acc, const pg8::Unit& u, int wr, int wc, int fr, int fq) const {
        const int row0 = u.pm * 256 + wr * 64 + fr, col0 = u.pn * 256 + wc * 32 + 8 * fq;
#pragma unroll
        for (int ai = 0; ai < 2; ++ai)
#pragma unroll
            for (int m = 0; m < 4; ++m) { const size_t ro = (size_t)(row0 + ai * 128 + m * 16) * 1024 + col0;
#pragma unroll
                for (int bj = 0; bj < 2; ++bj) { const f32x4 v0 = acc[ai][bj][m][0], v1 = acc[ai][bj][m][1];
                    const u32x4 ga = *(const u32x4*)(Ga + ro + bj * 128);
                    f32x4 o0, o1;
                    if (MODE == 0) {
                        o0 = (f32x4){bflo(ga.x) * v0[0], bfhi(ga.x) * v0[1], bflo(ga.y) * v0[2], bfhi(ga.y) * v0[3]};
                        o1 = (f32x4){bflo(ga.z) * v1[0], bfhi(ga.z) * v1[1], bflo(ga.w) * v1[2], bfhi(ga.w) * v1[3]};
                    } else {
                        const u32x4 gb = *(const u32x4*)(Gb + ro + bj * 128);
                        o0 = (f32x4){bflo(ga.x) + bflo(gb.x) * v0[0], bfhi(ga.x) + bfhi(gb.x) * v0[1], bflo(ga.y) + bflo(gb.y) * v0[2], bfhi(ga.y) + bfhi(gb.y) * v0[3]};
                        o1 = (f32x4){bflo(ga.z) + bflo(gb.z) * v1[0], bfhi(ga.z) + bfhi(gb.z) * v1[1], bflo(ga.w) + bflo(gb.w) * v1[2], bfhi(ga.w) + bfhi(gb.w) * v1[3]};
                    }
                    *(u32x4*)(Ga + ro + bj * 128) = pack8(o0, o1); } }
    }
};

template <class Epi>
__device__ __forceinline__ void run_gemm(LAS unsigned char* lds, const bf16_t* A, const bf16_t* Bt, int N, int K, const Epi& E, int ksplit = 1, int lda = 0, int ldb = 0, int eva = 256) {
    pg8::Gemm g; g.A = A; g.Bt = Bt; g.M = T_ALL; g.N = N; g.K = K / ksplit; g.lda = lda ? lda : K; g.ldb = ldb ? ldb : K; g.eva = eva;
    pg8::StaticOrder S; S.init(T_ALL, N, ksplit, gridDim.x, blockIdx.x);
    pg8::gemm_phase<Epi>(lds, g, S, E);
}

struct ConvJob { const float* src; bf16_t* dst; int ldsrc, ldd; };
__device__ __forceinline__ ConvJob conv_decode(const Params& p, int it) {
    unsigned char* ws = p.ws; ConvJob j; int t = it; int k0, c0, n0, kd0;
    if (t < 2816) {
        const int l = t / 1408; t -= l * 1408; const int ntile = t >> 4, kt = t & 15; n0 = ntile * 64;
        const int blk = n0 >> 8, within = n0 & 255, bj = within >> 7; c0 = bj * DFF + blk * 128 + (within & 127); k0 = kt * 64; kd0 = k0;
        j.src = p.in[9] + (size_t)l * 1024 * 5632; j.ldsrc = 5632; j.dst = (bf16_t*)(ws + (l ? WS_WIN1 : WS_WIN0)); j.ldd = 1024;
    } else if ((t -= 2816) < 1408) {
        const int l = t / 704; t -= l * 704; const int ntile = t / 44, kt = t % 44; n0 = ntile * 64; c0 = n0; k0 = kt * 64; kd0 = k0;
        j.src = p.in[10] + (size_t)l * DFF * 1024; j.ldsrc = 1024; j.dst = (bf16_t*)(ws + (l ? WS_WOUT1 : WS_WOUT0)); j.ldd = DFF;
    } else if ((t -= 1408) < 640) {
        const int ntile = t >> 4, kt = t & 15; n0 = 1024 + ntile * 64; c0 = 512 + ntile * 64; k0 = kt * 64; kd0 = k0;
        j.src = p.in[11]; j.ldsrc = 5120; j.dst = (bf16_t*)(ws + WS_WMIXA); j.ldd = 1024;
    } else if ((t -= 640) < 512) {
        const int ntile = t >> 4, kt = t & 15; n0 = ntile * 64;
        const int blk = n0 >> 8, within = n0 & 255, bj = within >> 7; c0 = 3072 + bj * 1024 + blk * 128 + (within & 127); k0 = kt * 64; kd0 = k0;
        j.src = p.in[11]; j.ldsrc = 5120; j.dst = (bf16_t*)(ws + WS_WGATE); j.ldd = 1024;
    } else if ((t -= 512) < 128) {
        const int ntile = t >> 3, kt = t & 7; n0 = ntile * 64; c0 = n0; k0 = kt * 64; kd0 = k0;
        j.src = p.in[12]; j.ldsrc = 1024; j.dst = (bf16_t*)(ws + WS_WFOUR); j.ldd = 512;
    } else if ((t -= 128) < 128) {
        const int ntile = t >> 3, kt = t & 7; n0 = ntile * 64; c0 = n0; k0 = kt * 64; kd0 = k0;
        j.src = p.in[14]; j.ldsrc = 1024; j.dst = (bf16_t*)(ws + WS_WHGRN); j.ldd = 512;
    } else { t -= 128;
        const int ntile = t >> 4, kt = t & 15; n0 = ntile * 64; c0 = n0; k0 = kt * 64; kd0 = k0;
        j.src = p.in[15]; j.ldsrc = 1024; j.dst = (bf16_t*)(ws + WS_WO); j.ldd = 1024;
    }
    j.src += (size_t)k0 * j.ldsrc + c0; j.dst += (size_t)n0 * j.ldd + kd0;
    return j;
}

__device__ __forceinline__ void fold_items(const Params& p, LAS unsigned char* lds, int first, int stride) {
    const int tid = threadIdx.x; unsigned char* ws = p.ws;
    {
        LAS float* Wl = (LAS float*)lds; LAS float* ct = Wl + 32 * 128; LAS float* st = ct + 128;
        const float* win = p.in[11]; bf16_t* wmix = (bf16_t*)(ws + WS_WMIXA);
        for (int item = first; item < 128; item += stride) {
            const int g = item >> 5, k0 = (item & 31) * 32;
            for (int i = tid; i < 32 * 32; i += 512) { const int kk = i >> 5, c4 = i & 31; const f32x4 v = *(const f32x4*)(win + (size_t)(k0 + kk) * 5120 + g * 128 + 4 * c4);
#pragma unroll
                for (int e = 0; e < 4; ++e) Wl[kk * 128 + 4 * c4 + e] = v[e]; }
            if (tid < 128) { const float ph = (float)tid * (1.f / 128.f); ct[tid] = __builtin_amdgcn_cosf(ph) * 0.08838834764831845f; st[tid] = __builtin_amdgcn_sinf(ph) * 0.08838834764831845f; }
            __syncthreads();
            const int np = tid & 255, part = np >> 7, chp = np & 127, kh = tid >> 8;
            LAS float* tw = part ? st : ct;
            float acc[16];
#pragma unroll
            for (int e = 0; e < 16; ++e) acc[e] = 0.f;
            for (int ch = 0; ch < 128; ++ch) { const float t = tw[(ch * chp) & 127];
#pragma unroll
                for (int e = 0; e < 16; ++e) acc[e] += Wl[(16 * kh + e) * 128 + ch] * t; }
            bf16_t* d = wmix + (size_t)(g * 256 + np) * 1024 + k0 + 16 * kh;
            *(u32x4*)d = pack8((f32x4){acc[0], acc[1], acc[2], acc[3]}, (f32x4){acc[4], acc[5], acc[6], acc[7]});
            *(u32x4*)(d + 8) = pack8((f32x4){acc[8], acc[9], acc[10], acc[11]}, (f32x4){acc[12], acc[13], acc[14], acc[15]});
            __syncthreads();
        }
    }
}

template <bool EARLY>
__device__ __forceinline__ void conv_tiles(const Params& p, LAS unsigned char* lds, int first, int stride) {
    const int tid = threadIdx.x;
    constexpr int NT = EARLY ? 2112 : 3776;
    auto tmap = [](int i) { return EARLY ? (i < 1408 ? i : 2816 + (i - 1408)) : (i < 1408 ? 1408 + i : (i < 2112 ? 3520 + (i - 1408) : 4224 + (i - 2112))); };
    {
        LAS float* tile = (LAS float*)lds;
        const int c4 = tid & 15, kk = tid >> 4, nn = tid >> 3, ko = tid & 7;
        int it = first;
        f32x4 v0 = (f32x4){0.f, 0.f, 0.f, 0.f}, v1 = v0; ConvJob cur{};
        if (it < NT) { cur = conv_decode(p, tmap(it)); v0 = *(const f32x4*)(cur.src + (size_t)kk * cur.ldsrc + 4 * c4); v1 = *(const f32x4*)(cur.src + (size_t)(kk + 32) * cur.ldsrc + 4 * c4); }
        while (it < NT) {
            const int itn = it + stride;
#pragma unroll
            for (int e = 0; e < 4; ++e) { tile[kk * 65 + 4 * c4 + e] = v0[e]; tile[(kk + 32) * 65 + 4 * c4 + e] = v1[e]; }
            ConvJob nxt{};
            if (itn < NT) { nxt = conv_decode(p, tmap(itn)); v0 = *(const f32x4*)(nxt.src + (size_t)kk * nxt.ldsrc + 4 * c4); v1 = *(const f32x4*)(nxt.src + (size_t)(kk + 32) * nxt.ldsrc + 4 * c4); }
            asm volatile("s_waitcnt lgkmcnt(0)" ::: "memory"); __builtin_amdgcn_s_barrier(); asm volatile("" ::: "memory");
            { f32x4 a, b;
#pragma unroll
                for (int e = 0; e < 4; ++e) { a[e] = tile[(ko * 8 + e) * 65 + nn]; b[e] = tile[(ko * 8 + 4 + e) * 65 + nn]; }
                *(u32x4*)(cur.dst + (size_t)nn * cur.ldd + ko * 8) = pack8(a, b); }
            asm volatile("s_waitcnt lgkmcnt(0)" ::: "memory"); __builtin_amdgcn_s_barrier(); asm volatile("" ::: "memory");
            cur = nxt; it = itn;
        }
    }
}

__device__ __forceinline__ void phase0(const Params& p, LAS unsigned char* lds) {
    const int tid = threadIdx.x;
    unsigned char* ws = p.ws;
    {
        LAS float* sc = (LAS float*)lds; LAS float* red = sc + 9216;
        const float* cvec = p.in[3]; const float* cctx = p.in[4]; const float* wmod = p.in[5]; const float* bmod = p.in[6];
        float* mod = (float*)(ws + WS_MOD);
        for (int i = tid; i < 9216; i += 512) { const int c = i >> 10, k = i & 1023; const float x = c == 0 ? cctx[k] : cvec[(c - 1) * 1024 + k]; sc[i] = silu_f(x); }
        __syncthreads();
        for (int item = blockIdx.x; item < 256; item += gridDim.x) {
            const int n0 = item * 36, cq = tid % 9, kg = tid / 9;
            float acc[9][4];
#pragma unroll
            for (int c = 0; c < 9; ++c)
#pragma unroll
                for (int e = 0; e < 4; ++e) acc[c][e] = 0.f;
            if (kg < 56) {
                for (int k = kg; k < 1024; k += 56) { const f32x4 w = *(const f32x4*)(wmod + (size_t)k * 9216 + n0 + 4 * cq);
#pragma unroll
                    for (int c = 0; c < 9; ++c) { const float s = sc[c * 1024 + k];
#pragma unroll
                        for (int e = 0; e < 4; ++e) acc[c][e] += s * w[e]; } }
#pragma unroll
                for (int c = 0; c < 9; ++c)
#pragma unroll
                    for (int e = 0; e < 4; ++e) red[(kg * 9 + cq) * 36 + c * 4 + e] = acc[c][e];
            }
            __syncthreads();
            if (tid < 324) { const int cq2 = tid / 36, rem = tid % 36, c = rem >> 2, e = rem & 3; float s = 0.f;
                for (int g = 0; g < 56; ++g) s += red[(g * 9 + cq2) * 36 + rem];
                mod[c * 9216 + n0 + 4 * cq2 + e] = s + bmod[n0 + 4 * cq2 + e]; }
            __syncthreads();
        }
    }
    {
        const int gt = blockIdx.x * 512 + tid, gs = gridDim.x * 512;
        const float* lbl = p.in[16]; float* lb = (float*)(ws + WS_LB);
        for (int i = gt; i < 1024; i += gs) lb[i] = 1.f / (1.f + __expf(lbl[1024 + i] - lbl[i]));
        bf16_t* ttc = (bf16_t*)(ws + WS_TTC); bf16_t* tt2 = (bf16_t*)(ws + WS_TT2); bf16_t* tt3 = (bf16_t*)(ws + WS_TT3);
        for (int i = gt; i < 256 * 512; i += gs) { const int n = i >> 9, kk = i & 511, pos = kk & 255; const float ph = (float)((n * pos) & 255) * (1.f / 256.f);
            const float v = (kk < 256 ? __builtin_amdgcn_cosf(ph) : -__builtin_amdgcn_sinf(ph)) * (1.f / 16.f); ttc[i] = f2bf(v); }
        for (int i = gt; i < 128 * 128; i += gs) { const int n = i >> 7, kk = i & 127, pos = kk & 63, np = n & 63; const float ph = (float)((np * pos) & 63) * (1.f / 64.f);
            const float cs = __builtin_amdgcn_cosf(ph), sn = __builtin_amdgcn_sinf(ph);
            const float v = (n < 64) ? (kk < 64 ? cs : -sn) : (kk < 64 ? sn : cs); tt2[i] = f2bf(v * 0.125f); }
        for (int i = gt; i < 64 * 128; i += gs) { const int n = i >> 7, kk = i & 127, pos = kk & 63; const float ph = (float)((n * pos) & 63) * (1.f / 64.f);
            const float v = (kk < 64 ? __builtin_amdgcn_cosf(ph) : -__builtin_amdgcn_sinf(ph)) * 0.125f; tt3[i] = f2bf(v); }
    }
    fold_items(p, lds, (int)blockIdx.x, (int)gridDim.x);
    conv_tiles<true>(p, lds, (int)blockIdx.x, (int)gridDim.x);
}

template <int MODE>
__device__ __forceinline__ void seam_phase(const Params& p) {
    constexpr int NR = 2;
    const int wid = threadIdx.x >> 6, lane = threadIdx.x & 63;
    const float* mod = (const float*)(p.ws + WS_MOD);
    bf16_t* HF = (bf16_t*)(p.ws + WS_HF); const bf16_t* F2 = (const bf16_t*)(p.ws + WS_S);
    bf16_t* XB1 = (bf16_t*)p.out; bf16_t* XB2 = (bf16_t*)(p.ws + WS_R + (size_t)T_ALL * DFF * 2);
    const float* npre = p.in[7]; const float* npost = p.in[8];
    constexpr int pi = MODE >= 1 ? MODE - 1 : 0, gi = MODE >= 1 ? 2 + 3 * (MODE - 1) : 0, pj = MODE <= 2 ? MODE : 0;
    constexpr float wgt = (MODE == 2) ? 1.f : 0.5f;
    const int nwaves = gridDim.x * 8, gw = blockIdx.x * 8 + wid;
    const int rpw = ((T_ALL + nwaves - 1) / nwaves + NR - 1) / NR * NR;
    const int rbeg = gw * rpw, rend = (rbeg + rpw < T_ALL) ? rbeg + rpw : T_ALL;
    f32x4 vnpost[4], vnpre[4], vg[4], vsh[4], vsc[4];
#pragma unroll
    for (int i = 0; i < 4; ++i) { const int col = 256 * i + 4 * lane;
        vnpost[i] = (MODE >= 1) ? *(const f32x4*)(npost + pi * 1024 + col) : (f32x4){0.f, 0.f, 0.f, 0.f};
        vnpre[i] = (MODE <= 2) ? *(const f32x4*)(npre + pj * 1024 + col) : (f32x4){0.f, 0.f, 0.f, 0.f};
        vg[i] = vsh[i] = vsc[i] = (f32x4){0.f, 0.f, 0.f, 0.f}; }
    int cur = -1;
    for (int row0 = rbeg; row0 < rend; row0 += NR) {
        f32x4 x[NR][4]; f32x4 f[NR][4];
#pragma unroll
        for (int r = 0; r < NR; ++r) { const int row = row0 + r;
            if (MODE <= 1) { const float* xsrc = row < T_CTX ? p.in[0] + (size_t)row * 1024 : p.in[1] + (size_t)(row - T_CTX) * 1024;
#pragma unroll
                for (int i = 0; i < 4; ++i) x[r][i] = *(const f32x4*)(xsrc + 256 * i + 4 * lane); }
            else { const bf16_t* xb = (MODE == 2 ? XB1 : XB2) + (size_t)row * 1024;
#pragma unroll
                for (int i = 0; i < 4; ++i) { const u32x2 w = *(const u32x2*)(xb + 256 * i + 4 * lane); x[r][i] = (f32x4){bflo(w.x), bfhi(w.x), bflo(w.y), bfhi(w.y)}; } }
            if (MODE >= 1) {
#pragma unroll
                for (int i = 0; i < 4; ++i) { const u32x2 w = *(const u32x2*)(HF + (size_t)row * 1024 + 256 * i + 4 * lane); f[r][i] = (f32x4){bflo(w.x), bfhi(w.x), bflo(w.y), bfhi(w.y)};
                    if (MODE != 2 && FFN_KSPLIT == 2) { const u32x2 w2 = *(const u32x2*)(F2 + (size_t)row * 1024 + 256 * i + 4 * lane);
                        f[r][i] += (f32x4){bflo(w2.x), bfhi(w2.x), bflo(w2.y), bfhi(w2.y)}; } } }
        }
        const int cidx = row0 < T_CTX ? 0 : 1 + ((row0 - T_CTX) >> 12);
        if (cidx != cur) { cur = cidx; const float* modc = mod + cidx * 9216;
#pragma unroll
            for (int i = 0; i < 4; ++i) { const int col = 256 * i + 4 * lane;
                if (MODE >= 1) vg[i] = *(const f32x4*)(modc + gi * 1024 + col);
                if (MODE <= 2) { vsh[i] = *(const f32x4*)(modc + (3 * pj) * 1024 + col); vsc[i] = *(const f32x4*)(modc + (3 * pj + 1) * 1024 + col); } } }
        if (MODE >= 1) {
            float rF[NR];
#pragma unroll
            for (int r = 0; r < NR; ++r) { float ss = 0.f;
#pragma unroll
                for (int i = 0; i < 4; ++i)
#pragma unroll
                    for (int e = 0; e < 4; ++e) ss += f[r][i][e] * f[r][i][e];
                ss = wave_sum(ss); rF[r] = rsqrtf(ss * (1.f / 1024.f) + EPS); }
#pragma unroll
            for (int i = 0; i < 4; ++i) { const int col = 256 * i + 4 * lane;
#pragma unroll
                for (int r = 0; r < NR; ++r) {
#pragma unroll
                    for (int e = 0; e < 4; ++e) x[r][i][e] += wgt * vg[i][e] * (f[r][i][e] * rF[r] * vnpost[i][e]);
                    if (MODE == 3) *(f32x4*)(p.out + (size_t)(row0 + r) * 1024 + col) = x[r][i];
                    else { u32x2 w; w.x = cvt_pk_bf16(x[r][i][0], x[r][i][1]); w.y = cvt_pk_bf16(x[r][i][2], x[r][i][3]);
                        *(u32x2*)((MODE == 1 ? XB1 : XB2) + (size_t)(row0 + r) * 1024 + col) = w;
                        x[r][i] = (f32x4){bflo(w.x), bfhi(w.x), bflo(w.y), bfhi(w.y)}; } } }
        }
        if (MODE <= 2) {
            float rinv[NR];
#pragma unroll
            for (int r = 0; r < NR; ++r) { float ss = 0.f;
#pragma unroll
                for (int i = 0; i < 4; ++i)
#pragma unroll
                    for (int e = 0; e < 4; ++e) ss += x[r][i][e] * x[r][i][e];
                ss = wave_sum(ss); rinv[r] = rsqrtf(ss * (1.f / 1024.f) + EPS); }
#pragma unroll
            for (int i = 0; i < 4; ++i) { const int col = 256 * i + 4 * lane;
#pragma unroll
                for (int r = 0; r < NR; ++r) { f32x4 h;
#pragma unroll
                    for (int e = 0; e < 4; ++e) h[e] = x[r][i][e] * rinv[r] * vnpre[i][e] * (1.f + vsc[i][e]) + vsh[i][e];
                    u32x2 w; w.x = cvt_pk_bf16(h[0], h[1]); w.y = cvt_pk_bf16(h[2], h[3]);
                    *(u32x2*)(HF + (size_t)(row0 + r) * 1024 + col) = w; } }
        }
    }
}

template <int CH, int NPOS, int NOUT, int MODE>
__device__ __forceinline__ void fourier_item(LAS unsigned char* lds, bf16_t* PZ, int tok0, int tstride, int colbase, const bf16_t* TT) {
    constexpr int LDX = 2 * NPOS + 8, K = 2 * NPOS, MT = CH / 16, NCHUNK = NPOS * 2 * (CH / 8);
    const int tid = threadIdx.x, wid = tid >> 6, lane = tid & 63, fr = lane & 15, fq = lane >> 4;
    LAS bf16_t* X = (LAS bf16_t*)lds;
    for (int q = tid; q < NCHUNK / 2; q += 512) {
        const int pp = q % (NPOS / 2), rest = q / (NPOS / 2), oct = rest % (CH / 8), part = rest / (CH / 8), pos = 2 * pp;
        const bf16_t* g0 = PZ + (size_t)(tok0 + pos * tstride) * 1024 + colbase + part * 128 + oct * 8;
        const u32x4 v0 = *(const u32x4*)g0, v1 = *(const u32x4*)(g0 + (size_t)tstride * 1024);
        constexpr int LW = LDX / 2;
        LAS unsigned* d = (LAS unsigned*)(X + (oct * 8) * LDX + part * NPOS + pos);
        d[0 * LW] = (v0.x & 0xffffu) | (v1.x << 16); d[1 * LW] = (v0.x >> 16) | (v1.x & 0xffff0000u);
        d[2 * LW] = (v0.y & 0xffffu) | (v1.y << 16); d[3 * LW] = (v0.y >> 16) | (v1.y & 0xffff0000u);
        d[4 * LW] = (v0.z & 0xffffu) | (v1.z << 16); d[5 * LW] = (v0.z >> 16) | (v1.z & 0xffff0000u);
        d[6 * LW] = (v0.w & 0xffffu) | (v1.w << 16); d[7 * LW] = (v0.w >> 16) | (v1.w & 0xffff0000u);
    }
    __syncthreads();
    for (int nt = wid; nt < NOUT / 16; nt += 8) {
        f32x4 acc[MT];
#pragma unroll
        for (int mt = 0; mt < MT; ++mt) acc[mt] = (f32x4){0.f, 0.f, 0.f, 0.f};
        const bf16_t* tp = TT + (size_t)(16 * nt + fr) * K + 8 * fq;
#pragma unroll 4
        for (int ks = 0; ks < K / 32; ++ks) {
            const bf16x8 b = *(const bf16x8*)(tp + 32 * ks);
#pragma unroll
            for (int mt = 0; mt < MT; ++mt) { const bf16x8 a = *(const LAS bf16x8*)(X + (16 * mt + fr) * LDX + 32 * ks + 8 * fq);
                acc[mt] = __builtin_amdgcn_mfma_f32_16x16x32_bf16(a, b, acc[mt], 0, 0, 0); }
        }
        const int n = 16 * nt + fr;
        int token, col;
        if (MODE == 0) { token = tok0 + n; col = colbase; }
        else if (MODE == 1) { token = tok0 + (n & 63); col = colbase + (n >> 6) * 128; }
        else { token = tok0 + n * 64; col = colbase; }
        bf16_t* op = PZ + (size_t)token * 1024 + col + 4 * fq;
#pragma unroll
        for (int mt = 0; mt < MT; ++mt) { u32x2 w; w.x = cvt_pk_bf16(acc[mt][0], acc[mt][1]); w.y = cvt_pk_bf16(acc[mt][2], acc[mt][3]); *(u32x2*)(op + 16 * mt) = w; }
    }
    __syncthreads();
}

constexpr int H_LF = 0, H_B = 16384, H_QS = 32768, H_KS = 41472, H_KT = 50176, H_VT = 60672, H_AS = 71168, H_ST = 73728, H_OT = 108544, H_ER = 125440, H_EL = 125952;
__device__ __forceinline__ int tro(int r) { return 40 * r + 8 * (r >> 3); }
#define LDS_BAR() do { asm volatile("s_waitcnt lgkmcnt(0)" ::: "memory"); __builtin_amdgcn_s_barrier(); asm volatile("" ::: "memory"); } while (0)
struct HgrnPtrs { bf16_t* Pq; const bf16_t *Plff, *Plfb, *Pv, *Psg; const float* gain; };

template <bool OUT>
__device__ __forceinline__ void hgrn_pass(LAS unsigned char* lds, const HgrnPtrs& hp, int tokbase, int h, int dir, f32x4 (&Sm)[8], float* stash, float& dsum) {
    const int tid = threadIdx.x, wid = tid >> 6, lane = tid & 63, fr = lane & 15, fq = lane >> 4;
    const int t_ld = tid >> 4, oc = tid & 15;
    LAS float* LF = (LAS float*)(lds + H_LF); LAS float* Bc = (LAS float*)(lds + H_B);
    LAS bf16_t* QS = (LAS bf16_t*)(lds + H_QS); LAS bf16_t* KS = (LAS bf16_t*)(lds + H_KS);
    LAS bf16_t* KT = (LAS bf16_t*)(lds + H_KT); LAS bf16_t* VT = (LAS bf16_t*)(lds + H_VT);
    LAS bf16_t* AS = (LAS bf16_t*)(lds + H_AS); LAS bf16_t* ST = (LAS bf16_t*)(lds + H_ST);
    LAS float* OT = (LAS float*)(lds + H_OT);
    LAS float* ER = (LAS float*)(lds + H_ER); LAS float* EL = (LAS float*)(lds + H_EL);
    const bf16_t* Plf = dir ? hp.Plfb : hp.Plff;
    const int mid = dir ? 16 : 15, last = dir ? 0 : 31;
    const f32x4 g0 = *(const f32x4*)(hp.gain + h * 128 + oc * 8), g1 = *(const f32x4*)(hp.gain + h * 128 + oc * 8 + 4);
    u32x4 qv_n = (u32x4){0u, 0u, 0u, 0u}, lv_n, vv_n, sg_n = (u32x4){0u, 0u, 0u, 0u};
    { const size_t ro = (size_t)(tokbase + 32 * (dir ? 7 : 0) + t_ld) * 512 + h * 128 + oc * 8;
        if (OUT) qv_n = *(const u32x4*)(hp.Pq + ro);
        lv_n = *(const u32x4*)(Plf + ro); vv_n = *(const u32x4*)(hp.Pv + ro);
        if (OUT && dir) sg_n = *(const u32x4*)(hp.Psg + ro); }
#pragma unroll 1
    for (int cc = 0; cc < 8; ++cc) {
        const int c = dir ? 7 - cc : cc;
        const size_t rowoff = (size_t)(tokbase + 32 * c + t_ld) * 512 + h * 128 + oc * 8;
        const u32x4 qv = qv_n, lv = lv_n, vv = vv_n, sg = sg_n;
        if (cc < 7) { const size_t ro = (size_t)(tokbase + 32 * (dir ? 6 - cc : cc + 1) + t_ld) * 512 + h * 128 + oc * 8;
            if (OUT) qv_n = *(const u32x4*)(hp.Pq + ro);
            lv_n = *(const u32x4*)(Plf + ro); vv_n = *(const u32x4*)(hp.Pv + ro);
            if (OUT && dir) sg_n = *(const u32x4*)(hp.Psg + ro); }
        float lf[8] = {bflo(lv.x), bfhi(lv.x), bflo(lv.y), bfhi(lv.y), bflo(lv.z), bfhi(lv.z), bflo(lv.w), bfhi(lv.w)};
        *(LAS f32x4*)(LF + t_ld * 128 + oc * 8) = (f32x4){lf[0], lf[1], lf[2], lf[3]};
        *(LAS f32x4*)(LF + t_ld * 128 + oc * 8 + 4) = (f32x4){lf[4], lf[5], lf[6], lf[7]};
        { LAS bf16_t* d = VT + tro(oc * 8) + t_ld;
            d[0] = (bf16_t)(vv.x & 0xffffu); d[40] = (bf16_t)(vv.x >> 16); d[80] = (bf16_t)(vv.y & 0xffffu); d[120] = (bf16_t)(vv.y >> 16);
            d[160] = (bf16_t)(vv.z & 0xffffu); d[200] = (bf16_t)(vv.z >> 16); d[240] = (bf16_t)(vv.w & 0xffffu); d[280] = (bf16_t)(vv.w >> 16); }
        LDS_BAR();
        {
            const int k = tid & 127, part = tid >> 7; float pre = 0.f;
            if (!dir) { for (int t = 0; t < 8 * part; ++t) pre += LF[t * 128 + k];
#pragma unroll
                for (int e = 0; e < 8; ++e) { const int t = 8 * part + e; pre += LF[t * 128 + k]; Bc[t * 128 + k] = pre; } }
            else { for (int t = 31; t >= 8 * (part + 1); --t) pre += LF[t * 128 + k];
#pragma unroll
                for (int e = 7; e >= 0; --e) { const int t = 8 * part + e; pre += LF[t * 128 + k]; Bc[t * 128 + k] = pre; } }
            if (OUT && part == (dir ? 2 : 1)) ER[k] = __expf(pre);
            if (part == (dir ? 0 : 3)) EL[k] = __expf(pre);
        }
        LDS_BAR();
        {
            const f32x4 b0 = *(const LAS f32x4*)(Bc + t_ld * 128 + oc * 8), b1 = *(const LAS f32x4*)(Bc + t_ld * 128 + oc * 8 + 4);
            const f32x4 r0 = *(const LAS f32x4*)(Bc + mid * 128 + oc * 8), r1 = *(const LAS f32x4*)(Bc + mid * 128 + oc * 8 + 4);
            const f32x4 l0 = *(const LAS f32x4*)(Bc + last * 128 + oc * 8), l1 = *(const LAS f32x4*)(Bc + last * 128 + oc * 8 + 4);
            const float q8[8] = {bflo(qv.x), bfhi(qv.x), bflo(qv.y), bfhi(qv.y), bflo(qv.z), bfhi(qv.z), bflo(qv.w), bfhi(qv.w)};
            float qs[8], ks[8], kh[8];
#pragma unroll
            for (int j = 0; j < 8; ++j) { const float b = j < 4 ? b0[j & 3] : b1[j & 3], r = j < 4 ? r0[j & 3] : r1[j & 3], bl = j < 4 ? l0[j & 3] : l1[j & 3];
                const float kk = 1.f - __expf(lf[j]);
                if (OUT) { qs[j] = q8[j] * __expf(b - r); ks[j] = kk * __expf(r - b); }
                kh[j] = kk * __expf(bl - b); }
            if (OUT) {
                *(LAS u32x4*)(QS + t_ld * 136 + oc * 8) = pack8((f32x4){qs[0], qs[1], qs[2], qs[3]}, (f32x4){qs[4], qs[5], qs[6], qs[7]});
                *(LAS u32x4*)(KS + t_ld * 136 + oc * 8) = pack8((f32x4){ks[0], ks[1], ks[2], ks[3]}, (f32x4){ks[4], ks[5], ks[6], ks[7]});
            }
            LAS bf16_t* d = KT + tro(oc * 8) + t_ld;
#pragma unroll
            for (int j = 0; j < 8; ++j) d[j * 40] = f2bf(kh[j]);
            if (OUT) {
#pragma unroll
                for (int kt = 0; kt < 8; ++kt) { const f32x4 r4 = *(const LAS f32x4*)(ER + 16 * kt + 4 * fq);
                    u32x2 w; w.x = cvt_pk_bf16(Sm[kt][0] * r4[0], Sm[kt][1] * r4[1]); w.y = cvt_pk_bf16(Sm[kt][2] * r4[2], Sm[kt][3] * r4[3]);
                    *(LAS u32x2*)(ST + (16 * wid + fr) * 136 + 16 * kt + 4 * fq) = w; }
            }
        }
        LDS_BAR();
        f32x4 ao[2] = {(f32x4){0.f, 0.f, 0.f, 0.f}, (f32x4){0.f, 0.f, 0.f, 0.f}};
        if (OUT) {
#pragma unroll
            for (int ks = 0; ks < 4; ++ks) { const bf16x8 b = *(const LAS bf16x8*)(ST + (16 * wid + fr) * 136 + 32 * ks + 8 * fq);
#pragma unroll
                for (int ti = 0; ti < 2; ++ti) { const bf16x8 a = *(const LAS bf16x8*)(QS + (16 * ti + fr) * 136 + 32 * ks + 8 * fq);
                    ao[ti] = __builtin_amdgcn_mfma_f32_16x16x32_bf16(a, b, ao[ti], 0, 0, 0); } }
            if (wid < 4) { const int ti = wid >> 1, si = wid & 1; f32x4 aa = (f32x4){0.f, 0.f, 0.f, 0.f};
#pragma unroll
                for (int ks = 0; ks < 4; ++ks) { const bf16x8 a = *(const LAS bf16x8*)(QS + (16 * ti + fr) * 136 + 32 * ks + 8 * fq);
                    const bf16x8 b = *(const LAS bf16x8*)(KS + (16 * si + fr) * 136 + 32 * ks + 8 * fq);
                    aa = __builtin_amdgcn_mfma_f32_16x16x32_bf16(a, b, aa, 0, 0, 0); }
                const int s = 16 * si + fr;
#pragma unroll
                for (int j = 0; j < 4; ++j) { const int t = 16 * ti + 4 * fq + j; const bool keep = dir ? (s >= t) : (s <= t);
                    AS[t * 40 + s] = f2bf(keep ? aa[j] : 0.f); } }
            LDS_BAR();
        }
        const bf16x8 vfrag = *(const LAS bf16x8*)(VT + tro(16 * wid + fr) + 8 * fq);
        if (OUT) {
#pragma unroll
            for (int ti = 0; ti < 2; ++ti) { const bf16x8 a = *(const LAS bf16x8*)(AS + (16 * ti + fr) * 40 + 8 * fq);
                ao[ti] = __builtin_amdgcn_mfma_f32_16x16x32_bf16(a, vfrag, ao[ti], 0, 0, 0); }
            float* sp = stash + ((size_t)(c * 2) * 512 + tid) * 4;
            if (!dir) { *(f32x4*)sp = ao[0]; *(f32x4*)(sp + 2048) = ao[1]; }
            else { const f32x4 s0 = *(const f32x4*)sp, s1 = *(const f32x4*)(sp + 2048);
#pragma unroll
                for (int j = 0; j < 4; ++j) { OT[(4 * fq + j) * 132 + 16 * wid + fr] = ao[0][j] + s0[j]; OT[(16 + 4 * fq + j) * 132 + 16 * wid + fr] = ao[1][j] + s1[j]; } }
        }
#pragma unroll
        for (int kt = 0; kt < 8; ++kt) { const f32x4 bl4 = *(const LAS f32x4*)(EL + 16 * kt + 4 * fq);
            const bf16x8 a = *(const LAS bf16x8*)(KT + tro(16 * kt + fr) + 8 * fq);
#pragma unroll
            for (int j = 0; j < 4; ++j) Sm[kt][j] *= bl4[j];
            Sm[kt] = __builtin_amdgcn_mfma_f32_16x16x32_bf16(a, vfrag, Sm[kt], 0, 0, 0); }
        if (!OUT && tid < 128) dsum += Bc[last * 128 + tid];
        LDS_BAR();
        if (OUT && dir) {
            const f32x4 o0 = *(const LAS f32x4*)(OT + t_ld * 132 + oc * 8), o1 = *(const LAS f32x4*)(OT + t_ld * 132 + oc * 8 + 4);
            float ss = 0.f;
#pragma unroll
            for (int e = 0; e < 4; ++e) ss += o0[e] * o0[e] + o1[e] * o1[e];
            ss += __shfl_xor(ss, 1); ss += __shfl_xor(ss, 2); ss += __shfl_xor(ss, 4); ss += __shfl_xor(ss, 8);
            const float rinv = rsqrtf(ss * (1.f / 128.f) + EPS);
            const f32x4 r0 = (f32x4){o0[0] * rinv * g0[0] * bflo(sg.x), o0[1] * rinv * g0[1] * bfhi(sg.x), o0[2] * rinv * g0[2] * bflo(sg.y), o0[3] * rinv * g0[3] * bfhi(sg.y)};
            const f32x4 r1 = (f32x4){o1[0] * rinv * g1[0] * bflo(sg.z), o1[1] * rinv * g1[1] * bfhi(sg.z), o1[2] * rinv * g1[2] * bflo(sg.w), o1[3] * rinv * g1[3] * bfhi(sg.w)};
            *(u32x4*)(hp.Pq + rowoff) = pack8(r0, r1);
        }
    }
}

__device__ __forceinline__ HgrnPtrs make_hp(const Params& p) {
    HgrnPtrs hp; unsigned char* R = p.ws + WS_R;
    hp.Pq = (bf16_t*)(R + R_PQ); hp.Plff = (const bf16_t*)(R + R_LFF); hp.Plfb = (const bf16_t*)(R + R_LFB); hp.Pv = (const bf16_t*)(R + R_PV); hp.Psg = (const bf16_t*)(R + R_SG);
    hp.gain = p.in[13]; return hp;
}

constexpr int A_LFF = 0, A_LFB = 16384, A_BF = 32768, A_BB = 49152, A_KTF = 65536, A_KTB = 76032, A_VT = 86528, A_ELF = 97024;
__device__ __forceinline__ void hgrn_phaseA(const Params& p, LAS unsigned char* lds) {
    const HgrnPtrs hp = make_hp(p);
    const int tid = threadIdx.x, wid = tid >> 6, lane = tid & 63, fr = lane & 15, fq = lane >> 4;
    const int t_ld = tid >> 4, oc = tid & 15;
    float* Sbuf = (float*)(p.ws + WS_S); float* Dbuf = (float*)(p.ws + WS_DB);
    LAS float* LFf = (LAS float*)(lds + A_LFF); LAS float* LFb = (LAS float*)(lds + A_LFB);
    LAS float* Bf = (LAS float*)(lds + A_BF); LAS float* Bb = (LAS float*)(lds + A_BB);
    LAS bf16_t* KTf = (LAS bf16_t*)(lds + A_KTF); LAS bf16_t* KTb = (LAS bf16_t*)(lds + A_KTB); LAS bf16_t* VT = (LAS bf16_t*)(lds + A_VT);
    LAS float* ELf = (LAS float*)(lds + A_ELF);
    for (int item = blockIdx.x; item < 512; item += gridDim.x) {
        const int b = item >> 6, seg = (item >> 2) & 15, h = item & 3, tokbase = T_CTX + b * 4096 + seg * 256;
        f32x4 Sf[8], Sb[8];
#pragma unroll
        for (int kt = 0; kt < 8; ++kt) { Sf[kt] = (f32x4){0.f, 0.f, 0.f, 0.f}; Sb[kt] = Sf[kt]; }
        float logP[8];
#pragma unroll
        for (int j = 0; j < 8; ++j) logP[j] = 0.f;
        float dsf = 0.f, dsb = 0.f;
        u32x4 lf_n, lb_n, vv_n;
        { const size_t ro = (size_t)(tokbase + t_ld) * 512 + h * 128 + oc * 8;
            lf_n = *(const u32x4*)(hp.Plff + ro); lb_n = *(const u32x4*)(hp.Plfb + ro); vv_n = *(const u32x4*)(hp.Pv + ro); }
#pragma unroll 1
        for (int c = 0; c < 8; ++c) {
            const u32x4 lvf = lf_n, lvb = lb_n, vv = vv_n;
            if (c < 7) { const size_t ro = (size_t)(tokbase + 32 * (c + 1) + t_ld) * 512 + h * 128 + oc * 8;
                lf_n = *(const u32x4*)(hp.Plff + ro); lb_n = *(const u32x4*)(hp.Plfb + ro); vv_n = *(const u32x4*)(hp.Pv + ro); }
            const float lff[8] = {bflo(lvf.x), bfhi(lvf.x), bflo(lvf.y), bfhi(lvf.y), bflo(lvf.z), bfhi(lvf.z), bflo(lvf.w), bfhi(lvf.w)};
            const float lfb[8] = {bflo(lvb.x), bfhi(lvb.x), bflo(lvb.y), bfhi(lvb.y), bflo(lvb.z), bfhi(lvb.z), bflo(lvb.w), bfhi(lvb.w)};
            *(LAS f32x4*)(LFf + t_ld * 128 + oc * 8) = (f32x4){lff[0], lff[1], lff[2], lff[3]}; *(LAS f32x4*)(LFf + t_ld * 128 + oc * 8 + 4) = (f32x4){lff[4], lff[5], lff[6], lff[7]};
            *(LAS f32x4*)(LFb + t_ld * 128 + oc * 8) = (f32x4){lfb[0], lfb[1], lfb[2], lfb[3]}; *(LAS f32x4*)(LFb + t_ld * 128 + oc * 8 + 4) = (f32x4){lfb[4], lfb[5], lfb[6], lfb[7]};
            { LAS bf16_t* d = VT + tro(oc * 8) + t_ld;
                d[0] = (bf16_t)(vv.x & 0xffffu); d[40] = (bf16_t)(vv.x >> 16); d[80] = (bf16_t)(vv.y & 0xffffu); d[120] = (bf16_t)(vv.y >> 16);
                d[160] = (bf16_t)(vv.z & 0xffffu); d[200] = (bf16_t)(vv.z >> 16); d[240] = (bf16_t)(vv.w & 0xffffu); d[280] = (bf16_t)(vv.w >> 16); }
            LDS_BAR();
            {
                const int k = tid & 127, part = (tid >> 7) & 1; const bool isb = tid >= 256;
                LAS float* src = isb ? LFb : LFf; LAS float* dst = isb ? Bb : Bf; float pre = 0.f;
                for (int t = 0; t < 16 * part; ++t) pre += src[t * 128 + k];
#pragma unroll
                for (int e = 0; e < 16; ++e) { const int t = 16 * part + e; pre += src[t * 128 + k]; dst[t * 128 + k] = pre; }
                if (!isb && part == 1) ELf[k] = __expf(pre);
            }
            LDS_BAR();
            {
                const f32x4 bf0 = *(const LAS f32x4*)(Bf + t_ld * 128 + oc * 8), bf1 = *(const LAS f32x4*)(Bf + t_ld * 128 + oc * 8 + 4);
                const f32x4 lf0 = *(const LAS f32x4*)(Bf + 31 * 128 + oc * 8), lf1 = *(const LAS f32x4*)(Bf + 31 * 128 + oc * 8 + 4);
                const f32x4 bb0 = *(const LAS f32x4*)(Bb + t_ld * 128 + oc * 8), bb1 = *(const LAS f32x4*)(Bb + t_ld * 128 + oc * 8 + 4);
                const f32x4 tb0 = *(const LAS f32x4*)(Bb + 31 * 128 + oc * 8), tb1 = *(const LAS f32x4*)(Bb + 31 * 128 + oc * 8 + 4);
                LAS bf16_t* df = KTf + tro(oc * 8) + t_ld; LAS bf16_t* db = KTb + tro(oc * 8) + t_ld;
#pragma unroll
                for (int j = 0; j < 8; ++j) { const float bfv = j < 4 ? bf0[j & 3] : bf1[j & 3], blf = j < 4 ? lf0[j & 3] : lf1[j & 3];
                    const float bbv = j < 4 ? bb0[j & 3] : bb1[j & 3], tb = j < 4 ? tb0[j & 3] : tb1[j & 3];
                    const float kf = (1.f - __expf(lff[j])) * __expf(blf - bfv);
                    const float kb = (1.f - __expf(lfb[j])) * __expf(logP[j] + bbv - lfb[j]);
                    df[j * 40] = f2bf(kf); db[j * 40] = f2bf(kb);
                    logP[j] += tb; }
            }
            if (tid < 128) { dsf += Bf[31 * 128 + tid]; dsb += Bb[31 * 128 + tid]; }
            LDS_BAR();
            const bf16x8 vfrag = *(const LAS bf16x8*)(VT + tro(16 * wid + fr) + 8 * fq);
#pragma unroll
            for (int kt = 0; kt < 8; ++kt) { const f32x4 e4 = *(const LAS f32x4*)(ELf + 16 * kt + 4 * fq);
                const bf16x8 af = *(const LAS bf16x8*)(KTf + tro(16 * kt + fr) + 8 * fq);
                const bf16x8 ab = *(const LAS bf16x8*)(KTb + tro(16 * kt + fr) + 8 * fq);
#pragma unroll
                for (int j = 0; j < 4; ++j) Sf[kt][j] *= e4[j];
                Sf[kt] = __builtin_amdgcn_mfma_f32_16x16x32_bf16(af, vfrag, Sf[kt], 0, 0, 0);
                Sb[kt] = __builtin_amdgcn_mfma_f32_16x16x32_bf16(ab, vfrag, Sb[kt], 0, 0, 0); }
            LDS_BAR();
        }
#pragma unroll 1
        for (int dir = 0; dir < 2; ++dir) {
            const size_t ci = (size_t)(((b * 4 + h) * 2 + dir) * 16 + seg);
            float* sp = Sbuf + ci * 16384;
#pragma unroll
            for (int kt = 0; kt < 8; ++kt)
#pragma unroll
                for (int j = 0; j < 4; ++j) sp[(16 * kt + 4 * fq + j) * 128 + 16 * wid + fr] = dir ? Sb[kt][j] : Sf[kt][j];
            if (tid < 128) Dbuf[ci * 128 + tid] = __expf(dir ? dsb : dsf);
        }
    }
}
__device__ __forceinline__ void hgrn_phaseB(const Params& p) {
    float* Sbuf = (float*)(p.ws + WS_S); const float* Dbuf = (const float*)(p.ws + WS_DB); const float* st = p.in[2];
    for (int idx = blockIdx.x * 512 + threadIdx.x; idx < 64 * 4096; idx += gridDim.x * 512) {
        const int chain = idx >> 12, e = idx & 4095, k = e >> 5, v4 = e & 31;
        const int b = chain >> 3, h = (chain >> 1) & 3, dir = chain & 1;
        f32x4 S = *(const f32x4*)(st + ((size_t)((b * 2 + dir) * 4 + h) * 128 + k) * 128 + 4 * v4);
        f32x4 L[16]; float dd[16];
#pragma unroll
        for (int i = 0; i < 16; ++i) { const int seg = dir ? 15 - i : i;
            L[i] = *(const f32x4*)(Sbuf + ((size_t)chain * 16 + seg) * 16384 + k * 128 + 4 * v4); dd[i] = Dbuf[((size_t)chain * 16 + seg) * 128 + k]; }
#pragma unroll
        for (int i = 0; i < 16; ++i) { const int seg = dir ? 15 - i : i;
            *(f32x4*)(Sbuf + ((size_t)chain * 16 + seg) * 16384 + k * 128 + 4 * v4) = S;
#pragma unroll
            for (int e2 = 0; e2 < 4; ++e2) S[e2] = dd[i] * S[e2] + L[i][e2]; }
    }
}
__device__ __forceinline__ void hgrn_phaseC(const Params& p, LAS unsigned char* lds) {
    const HgrnPtrs hp = make_hp(p);
    const int tid = threadIdx.x, wid = tid >> 6, lane = tid & 63, fr = lane & 15, fq = lane >> 4;
    const float* Sbuf = (const float*)(p.ws + WS_S);
    float* stash = (float*)(p.ws + WS_STASH) + (size_t)blockIdx.x * 32768;
    float* ostate = p.out + (size_t)T_ALL * 1024;
    for (int item = blockIdx.x; item < 640; item += gridDim.x) {
        const bool lat = item < 512;
        int b, seg = 0, h, tokbase;
        if (lat) { b = item >> 6; seg = (item >> 2) & 15; h = item & 3; tokbase = T_CTX + b * 4096 + seg * 256; }
        else { const int i2 = item - 512; b = i2 >> 2; h = i2 & 3; tokbase = b * 256; }
#pragma unroll 1
        for (int dir = 0; dir < 2; ++dir) {
            f32x4 Sm[8];
            if (lat) { const float* sp = Sbuf + (size_t)(((b * 4 + h) * 2 + dir) * 16 + seg) * 16384;
#pragma unroll
                for (int kt = 0; kt < 8; ++kt)
#pragma unroll
                    for (int j = 0; j < 4; ++j) Sm[kt][j] = sp[(16 * kt + 4 * fq + j) * 128 + 16 * wid + fr]; }
            else {
#pragma unroll
                for (int kt = 0; kt < 8; ++kt) Sm[kt] = (f32x4){0.f, 0.f, 0.f, 0.f}; }
            float dsum = 0.f;
            hgrn_pass<true>(lds, hp, tokbase, h, dir, Sm, stash, dsum);
            if (!lat) { float* sp = ostate + (size_t)((b * 2 + dir) * 4 + h) * 16384;
#pragma unroll
                for (int kt = 0; kt < 8; ++kt)
#pragma unroll
                    for (int j = 0; j < 4; ++j) sp[(16 * kt + 4 * fq + j) * 128 + 16 * wid + fr] = Sm[kt][j]; }
        }
    }
}


template <int PHN>
__device__ __forceinline__ void run_phase(const Params& p, LAS unsigned char* lds) {
    unsigned char* ws = p.ws;
    bf16_t* HF = (bf16_t*)(ws + WS_HF);
    bf16_t* ACT = (bf16_t*)(ws + WS_R);
    bf16_t* PZ = (bf16_t*)(ws + WS_R + R_PZ);
    bf16_t* PQ = (bf16_t*)(ws + WS_R + R_PQ);
    bf16_t* GA = (bf16_t*)(ws + WS_R + R_GA);
    bf16_t* GB = (bf16_t*)(ws + WS_R + R_GB);
    if constexpr (PHN == 0) phase0(p, lds);
    else if constexpr (PHN == 1) seam_phase<0>(p);
    else if constexpr (PHN == 2) { EpiSwiglu E; E.O = ACT; run_gemm(lds, HF, (const bf16_t*)(ws + WS_WIN0), 5632, 1024, E); }
    else if constexpr (PHN == 3) { EpiPlain E; E.O = HF; E.ldc = 1024; E.O1 = (bf16_t*)(ws + WS_S); run_gemm(lds, ACT, (const bf16_t*)(ws + WS_WOUT0), 1024, DFF, E, FFN_KSPLIT, DFF, DFF);
        const int nb = (int)gridDim.x, rem = 640 % nb; int first = (int)blockIdx.x, stride = nb;
        if (rem != 0) { first = (int)blockIdx.x - rem; stride = nb - rem; }
        if (first >= 0) { __syncthreads(); conv_tiles<false>(p, lds, first, stride); }
    }
    else if constexpr (PHN == 4) seam_phase<1>(p);
    else if constexpr (PHN == 5) { EpiMixA E; E.PZ = PZ; E.Pq = PQ; E.Plff = (bf16_t*)(ws + WS_R + R_LFF); E.Plfb = (bf16_t*)(ws + WS_R + R_LFB); E.Pv = (bf16_t*)(ws + WS_R + R_PV); E.Psg = (bf16_t*)(ws + WS_R + R_SG);
        E.lb = (const float*)(ws + WS_LB); run_gemm(lds, HF, (const bf16_t*)(ws + WS_WMIXA), 3584, 1024, E); }
    else if constexpr (PHN == 6) {
        hgrn_phaseA(p, lds);
        for (int it = blockIdx.x; it < 256; it += gridDim.x) { const int b = it >> 3, g = (it >> 1) & 3, slab = it & 1;
            fourier_item<64, 256, 256, 0>(lds, PZ, b * 256, 1, g * 256 + slab * 64, (const bf16_t*)(ws + WS_TTC)); }
        for (int it = blockIdx.x; it < 2048; it += gridDim.x) { const int b = it >> 8, r = (it >> 2) & 63, g = it & 3;
            fourier_item<128, 64, 128, 1>(lds, PZ, T_CTX + b * 4096 + r * 64, 1, g * 256, (const bf16_t*)(ws + WS_TT2)); }
    }
    else if constexpr (PHN == 7) hgrn_phaseB(p);
    else if constexpr (PHN == 8) {
        hgrn_phaseC(p, lds);
        const int nb = (int)gridDim.x, rem = 640 % nb;
        int first = 0, stride = nb;
        if (rem != 0) { first = rem; stride = nb - rem; }
        if ((int)blockIdx.x >= first) {
            __syncthreads();
            for (int it = (int)blockIdx.x - first; it < 2048; it += stride) { const int b = it >> 8, c = (it >> 2) & 63, g = it & 3;
                fourier_item<128, 64, 64, 2>(lds, PZ, T_CTX + b * 4096 + c, 64, g * 256, (const bf16_t*)(ws + WS_TT3)); }
        }
    }
    else if constexpr (PHN == 9) {
        { EpiPlain E; E.O = GA; E.ldc = 1024; run_gemm(lds, PZ, (const bf16_t*)(ws + WS_WFOUR), 1024, 512, E, 1, 1024, 512, 512); }
        { EpiPlain E; E.O = GB; E.ldc = 1024; run_gemm(lds, PQ, (const bf16_t*)(ws + WS_WHGRN), 1024, 512, E); }
    }
    else if constexpr (PHN == 10) { EpiGateMerge E; E.BA = GA; E.BB = GB; E.O = PZ; run_gemm(lds, HF, (const bf16_t*)(ws + WS_WGATE), 2048, 1024, E); }
    else if constexpr (PHN == 11) { EpiPlain E; E.O = HF; E.ldc = 1024; run_gemm(lds, PZ, (const bf16_t*)(ws + WS_WO), 1024, 1024, E); }
    else if constexpr (PHN == 12) seam_phase<2>(p);
    else if constexpr (PHN == 13) { EpiSwiglu E; E.O = ACT; run_gemm(lds, HF, (const bf16_t*)(ws + WS_WIN1), 5632, 1024, E); }
    else if constexpr (PHN == 14) { EpiPlain E; E.O = HF; E.ldc = 1024; E.O1 = (bf16_t*)(ws + WS_S); run_gemm(lds, ACT, (const bf16_t*)(ws + WS_WOUT1), 1024, DFF, E, FFN_KSPLIT, DFF, DFF); }
    else seam_phase<3>(p);
}
template <int... Ns> struct PhaseList {};
template <bool FIRST, int N0, int... Ns>
__device__ __forceinline__ void run_all(const Params& p, LAS unsigned char* lds, cg::grid_group& grid, XcdBarrier& xb, PhaseList<N0, Ns...>) {
    run_phase<N0>(p, lds);
    if constexpr (sizeof...(Ns) > 0) {
        if constexpr (FIRST) { grid.sync(); xb = xcd_barrier_post((unsigned*)(p.ws + WS_BAR), xb.st); }
        else xcd_barrier(xb);
        run_all<false>(p, lds, grid, xb, PhaseList<Ns...>{}); }
}
#ifndef SCHED_LIST
#define SCHED_LIST 0, 1, 2, 3, 4, 5, 6, 7, 8, 9, 10, 11, 12, 13, 14, 15
#endif
typedef PhaseList<SCHED_LIST> Sched;

__global__ void __launch_bounds__(512, 2) mk_forward(Params p) {
    extern __shared__ __attribute__((aligned(16))) unsigned char lds_raw[];
    LAS unsigned char* lds = (LAS unsigned char*)lds_raw;
    cg::grid_group grid = cg::this_grid();
    volatile LAS unsigned* st = (volatile LAS unsigned*)(lds + LDS_PHASE_BYTES);
    if (threadIdx.x == 0) { st[0] = 0u; st[1] = 0u; }
    __syncthreads();
    if (blockIdx.x == 0) { unsigned* bar = (unsigned*)(p.ws + WS_BAR); for (int i = threadIdx.x; i < XCD_BAR_WORDS; i += 512) bar[i] = 0u; }
    XcdBarrier xb; xb.bar = nullptr; xb.x = 0u; xb.st = st;
    run_all<true>(p, lds, grid, xb, Sched{});
}

extern "C" void kernel_launch(void* const* d_in, const int* in_sizes, int n_in, void* d_out, int out_size, void* d_ws, size_t ws_size, hipStream_t stream) {
    static int grid = 0;
    if (grid == 0) {
        if (n_in != 17 || ws_size < WS_END) { fprintf(stderr, "kernel_launch: need 17 inputs and >= %zu bytes of workspace; got %d, %zu\n", (size_t)WS_END, n_in, ws_size); grid = -1; return; }
        int dev = 0, cus = 0, per_cu = 0;
        if (hipGetDevice(&dev) != hipSuccess || hipDeviceGetAttribute(&cus, hipDeviceAttributeMultiprocessorCount, dev) != hipSuccess) { grid = -1; return; }
        if (hipFuncSetAttribute((const void*)mk_forward, hipFuncAttributeMaxDynamicSharedMemorySize, LDS_BYTES) != hipSuccess) { fprintf(stderr, "kernel_launch: hipFuncSetAttribute failed\n"); grid = -1; return; }
        if (hipOccupancyMaxActiveBlocksPerMultiprocessor(&per_cu, (const void*)mk_forward, 512, LDS_BYTES) != hipSuccess || per_cu < 1) { fprintf(stderr, "kernel_launch: occupancy query failed (%d)\n", per_cu); grid = -1; return; }
        grid = cus * per_cu; if (grid > 256) grid = 256;
    }
    if (grid < 0) return;
    Params p{};
    for (int i = 0; i < 17; ++i) p.in[i] = (const float*)d_in[i];
    p.out = (float*)d_out; p.ws = (unsigned char*)d_ws;
    void* args[] = {&p};
    hipError_t e = hipLaunchCooperativeKernel((const void*)mk_forward, dim3(grid), dim3(512), args, LDS_BYTES, stream);
    if (e != hipSuccess) fprintf(stderr, "cooperative launch failed: %s (grid %d)\n", hipGetErrorString(e), grid);
}
```

```cpp
#include <hip/hip_runtime.h>
#include <hip/hip_cooperative_groups.h>
#include <cstdio>
namespace cg = cooperative_groups;

#define LAS __attribute__((address_space(3)))
typedef unsigned short bf16_t;
typedef short bf16x8 __attribute__((ext_vector_type(8)));
typedef float f32x4 __attribute__((ext_vector_type(4)));
typedef unsigned u32x4 __attribute__((ext_vector_type(4)));
typedef unsigned u32x2 __attribute__((ext_vector_type(2)));

constexpr int T_ALL = 40960, T_CTX = 8192, DM = 1024, DFF = 2816;
constexpr float EPS = 1e-6f;
constexpr int LDS_PHASE_BYTES = 131072;
constexpr int LDS_BYTES = LDS_PHASE_BYTES + 16;
constexpr int NPHASE = 17;
constexpr int FFN_KSPLIT = 1;

constexpr size_t WS_WIN0 = 0;
constexpr size_t WS_WIN1 = WS_WIN0 + (size_t)5632 * 1024 * 2;
constexpr size_t WS_WOUT0 = WS_WIN1 + (size_t)5632 * 1024 * 2;
constexpr size_t WS_WOUT1 = WS_WOUT0 + (size_t)1024 * 2816 * 2;
constexpr size_t WS_WMIXA = WS_WOUT1 + (size_t)1024 * 2816 * 2;
constexpr size_t WS_WGATE = WS_WMIXA + (size_t)3584 * 1024 * 2;
constexpr size_t WS_WFOUR = WS_WGATE + (size_t)2048 * 1024 * 2;
constexpr size_t WS_WHGRN = WS_WFOUR + (size_t)1024 * 1024 * 2;
constexpr size_t WS_WO = WS_WHGRN + (size_t)1024 * 512 * 2;
constexpr size_t WS_TTC = WS_WO + (size_t)1024 * 1024 * 2;
constexpr size_t WS_TT2 = WS_TTC + (size_t)256 * 512 * 2;
constexpr size_t WS_TT3 = WS_TT2 + (size_t)128 * 128 * 2;
constexpr size_t WS_MOD = WS_TT3 + (size_t)64 * 128 * 2;
constexpr size_t WS_LB = WS_MOD + (size_t)9 * 9216 * 4;
constexpr size_t WS_DB = WS_LB + (size_t)1024 * 4;
constexpr size_t WS_BAR = WS_DB + (size_t)64 * 16 * 128 * 4;
constexpr size_t WS_HF = WS_BAR + 16384;
constexpr size_t WS_R = WS_HF + (size_t)T_ALL * 1024 * 2;
constexpr size_t R_PZ = 0;
constexpr size_t R_PQ = R_PZ + (size_t)T_ALL * 1024 * 2;
constexpr size_t R_LFF = R_PQ + (size_t)T_ALL * 512 * 2;
constexpr size_t R_LFB = R_LFF + (size_t)T_ALL * 512 * 2;
constexpr size_t R_PV = R_LFB + (size_t)T_ALL * 512 * 2;
constexpr size_t R_SG = R_PV + (size_t)T_ALL * 512 * 2;
constexpr size_t R_END = R_SG + (size_t)T_ALL * 512 * 2;
constexpr size_t R_GA = R_LFF;
constexpr size_t R_GB = R_GA + (size_t)T_ALL * 1024 * 2;
constexpr size_t WS_S = WS_R + R_END;
constexpr size_t WS_STASH = WS_S + (size_t)64 * 16 * 16384 * 4;
constexpr size_t WS_END = WS_STASH + (size_t)256 * 32768 * 4;

struct Params {
    const float* in[17];
    float* out;
    unsigned char* ws;
    int pad0, pad1;
};

typedef __bf16 bf16v2_t __attribute__((ext_vector_type(2)));
typedef float f32x2_t __attribute__((ext_vector_type(2)));
__device__ __forceinline__ unsigned cvt_pk_bf16(float lo, float hi) { const f32x2_t v = {lo, hi}; const bf16v2_t b = __builtin_convertvector(v, bf16v2_t); return __builtin_bit_cast(unsigned, b); }
__device__ __forceinline__ bf16_t f2bf(float f) { return (bf16_t)(cvt_pk_bf16(f, 0.f) & 0xffffu); }
__device__ __forceinline__ float bflo(unsigned w) { return __uint_as_float(w << 16); }
__device__ __forceinline__ float bfhi(unsigned w) { return __uint_as_float(w & 0xffff0000u); }
__device__ __forceinline__ float silu_f(float x) { return x * __builtin_amdgcn_rcpf(1.f + __builtin_amdgcn_exp2f(-1.44269504089f * x)); }
__device__ __forceinline__ float sigm_f(float x) { return __builtin_amdgcn_rcpf(1.f + __builtin_amdgcn_exp2f(-1.44269504089f * x)); }
__device__ __forceinline__ float wave_sum(float v) {
#pragma unroll
    for (int o = 32; o > 0; o >>= 1) v += __shfl_xor(v, o);
    return v;
}


#define XB_TMO      128
#define XB_XCNT(j)  (256  + 64 * (j))
#define XB_XSUB(j)  (1280 + 64 * (j))
#define XB_XGEN(j)  (2304 + 64 * (j))
#define XB_TOP      3328
#define XB_TOPGEN   3392
#define XCD_BAR_WORDS 3456
#define XB_SPIN_CAP (1u << 18)
__device__ __forceinline__ unsigned xb_ld(unsigned* p)              { return __hip_atomic_load(p, __ATOMIC_RELAXED, __HIP_MEMORY_SCOPE_AGENT); }
__device__ __forceinline__ unsigned xb_add(unsigned* p, unsigned v) { return __hip_atomic_fetch_add(p, v, __ATOMIC_RELAXED, __HIP_MEMORY_SCOPE_AGENT); }
__device__ __forceinline__ unsigned xb_xcc_id() { return (unsigned)__builtin_amdgcn_s_getreg((3 << 11) | 20) & 0xFu; }
#define XB_SPIN(cond, bar) do { unsigned _sp = 0; while (cond) { __builtin_amdgcn_s_sleep(6); \
    if ((++_sp & 255u) == 0u) { if (xb_ld(&(bar)[XB_TMO])) break; if (_sp > XB_SPIN_CAP) { atomicAdd(&(bar)[XB_TMO], 1u); break; } } } } while (0)
struct XcdBarrier { unsigned* bar; unsigned x; volatile LAS unsigned* st; };
__device__ __forceinline__ XcdBarrier xcd_barrier_post(unsigned* bar, volatile LAS unsigned* st) {
    XcdBarrier b; b.bar = bar; b.x = xb_xcc_id(); b.st = st;
    if (threadIdx.x == 0) (void)xb_add(&bar[XB_XCNT(b.x)], 1u);
    return b;
}
__device__ __forceinline__ void xcd_barrier_complete(unsigned* bar, unsigned x, unsigned& nloc, unsigned& nx) {
    const unsigned G = gridDim.x * gridDim.y * gridDim.z;
    unsigned sum, cnt, mine, sp = 0u;
    for (;;) {
        sum = 0u; cnt = 0u; mine = 0u;
#pragma unroll
        for (unsigned j = 0; j < 16; ++j) { const unsigned c = xb_ld(&bar[XB_XCNT(j)]); sum += c; cnt += (c > 0u) ? 1u : 0u; mine = (j == x) ? c : mine; }
        if (sum == G) break;
        __builtin_amdgcn_s_sleep(1);
        if ((++sp & 255u) == 0u) { if (xb_ld(&bar[XB_TMO])) break; if (sp > XB_SPIN_CAP) { atomicAdd(&bar[XB_TMO], 1u); break; } }
    }
    nloc = mine > 0u ? mine : 1u; nx = cnt > 0u ? cnt : 1u;
}
__device__ __forceinline__ void xcd_barrier(const XcdBarrier& b) {
    asm volatile("s_waitcnt vmcnt(0)" ::: "memory");
    __syncthreads();
    if (threadIdx.x == 0) {
        unsigned* bar = b.bar;
        __builtin_amdgcn_s_waitcnt(0);
        unsigned nloc = b.st[0], nx = b.st[1];
        if (nloc == 0u) { xcd_barrier_complete(bar, b.x, nloc, nx); b.st[0] = nloc; b.st[1] = nx; }
        const unsigned old = xb_add(&bar[XB_XSUB(b.x)], 1u);
        const unsigned gen = old / nloc;
        if (old + 1u == (gen + 1u) * nloc) {
            __builtin_amdgcn_fence(__ATOMIC_RELEASE, "agent");
            asm volatile("s_waitcnt vmcnt(0)" ::: "memory");
            const unsigned og = xb_add(&bar[XB_TOP], 1u);
            const unsigned tg = og / nx;
            if (og + 1u == (tg + 1u) * nx) xb_add(&bar[XB_TOPGEN], 1u);
            else XB_SPIN(xb_ld(&bar[XB_TOPGEN]) == tg, bar);
            __builtin_amdgcn_fence(__ATOMIC_ACQUIRE, "agent");
            xb_add(&bar[XB_XGEN(b.x)], 1u);
            asm volatile("s_waitcnt vmcnt(0)" ::: "memory");
        } else {
            XB_SPIN(xb_ld(&bar[XB_XGEN(b.x)]) == gen, bar);
            __builtin_amdgcn_fence(__ATOMIC_ACQUIRE, "agent");
            asm volatile("s_waitcnt vmcnt(0)" ::: "memory");
        }
    }
    __syncthreads();
}

namespace pg8 {
constexpr int BM = 256, BK = 64, HALF = 128, HTB = HALF * BK * 2, STAGE_BYTES = 8 * HTB, NXCD = 8, WGM = 8;
__device__ __forceinline__ int lds_byte(int r, int c) { const int st = (r >> 4) * 2 + (c >> 5), rr = r & 15, cc = c & 31, ob = rr * 64 + cc * 2; return st * 1024 + (ob ^ (((ob >> 9) & 1) << 5)); }
__device__ __forceinline__ void stage_rc(int b, int& R, int& C) { const int st = b / 1024, sb = b % 1024, swz = sb ^ (((sb >> 9) & 1) << 5); R = (st >> 1) * 16 + swz / 64; C = (st & 1) * 32 + (swz % 64) / 2; }
__device__ __forceinline__ int perm32(int rho) { const int n = rho >> 4, i = rho & 15; return 8 * (i >> 2) + 4 * n + (i & 3); }
struct Unit { int pm, pn, ks; };
struct Gemm { const bf16_t* A; const bf16_t* Bt; int M, N, K, lda, ldb, eva; };
struct StaticOrder {
    int nM, nN, nwg, nall, G, c;
    __device__ void init(int M, int N, int KS, int G_, int c_) { nM = M / BM; nN = N / BM; nwg = nM * nN; nall = nwg * KS; G = G_; c = c_; }
    __device__ bool next(int i, Unit& u) const {
        const long L = (long)i * G + c; if (L >= nall) return false;
        u.ks = (int)(L / nwg);
        int wgid = (int)(L % nwg); { const int q = nwg / NXCD, r = nwg % NXCD, xcd = wgid % NXCD, off = wgid / NXCD; wgid = (xcd < r ? xcd * (q + 1) : r * (q + 1) + (xcd - r) * q) + off; }
        const int nig = WGM * nN, gid = wgid / nig, fm = gid * WGM, gsz = (nM - fm) < WGM ? (nM - fm) : WGM;
        u.pm = fm + ((wgid % nig) % gsz); u.pn = (wgid % nig) / gsz; return true;
    }
};

template <class Epi>
__device__ __forceinline__ void gemm_phase(LAS unsigned char* lds, const Gemm g, const StaticOrder& S, const Epi& E) {
    const int tid = threadIdx.x, wid = __builtin_amdgcn_readfirstlane(tid >> 6), lane = tid & 63, wr = wid >> 2, wc = wid & 3, fr = lane & 15, fq = lane >> 4;
    const int K = g.K, nt = K / BK;
    unsigned voffA[2], voffB[2];
#pragma unroll
    for (int i = 0; i < 2; ++i) { int R, C; stage_rc(tid * 16 + i * 8192, R, C); const int Rb = (R & ~31) + perm32(R & 31);
        voffA[i] = (unsigned)(R * g.lda + C) * 2u; voffB[i] = (unsigned)(Rb * g.ldb + C) * 2u; }
    const size_t kstep = (size_t)(BK * 2);
    const size_t hstepA = (size_t)HALF * g.lda * 2, hstepB = (size_t)HALF * g.ldb * 2;
    const size_t tstepA = 2 * hstepA, tstepB = 2 * hstepB;
    const size_t eva = (size_t)g.eva, ksoffA = (size_t)(K / 128) * eva, ksoffB = (size_t)K * 2;
    const unsigned ldsw = (unsigned)wid * 1024u;
    const int aoff = lds_byte(wr * 64 + fr, fq * 8), boff = lds_byte(wc * 32 + fr, fq * 8);
#define PG8_SA(b, h) (((b) * 2 + (h)) * HTB)
#define PG8_SB(b, h) ((4 + (b) * 2 + (h)) * HTB)
#define PG8_STAGE(bufoff, gbase, voff) do { _Pragma("unroll") for (int _i = 0; _i < 2; ++_i) \
        __builtin_amdgcn_global_load_lds((const unsigned*)((const char*)(gbase) + (voff)[_i]), (LAS unsigned*)(lds + (bufoff) + ldsw + _i * 8192), 16, 0, 0); } while (0)
#define PG8_LDA(dst, b, h) do { _Pragma("unroll") for (int m = 0; m < 4; ++m) _Pragma("unroll") for (int k = 0; k < 2; ++k) dst[m][k] = *(const LAS bf16x8*)(lds + PG8_SA(b, h) + aoff + m * 2048 + k * 1024); } while (0)
#define PG8_LDB(dst, b, h) do { _Pragma("unroll") for (int n = 0; n < 2; ++n) _Pragma("unroll") for (int k = 0; k < 2; ++k) dst[n][k] = *(const LAS bf16x8*)(lds + PG8_SB(b, h) + boff + n * 2048 + k * 1024); } while (0)
#define PG8_MMA(ai, bj, At, Bt) do { __builtin_amdgcn_s_setprio(1); _Pragma("unroll") for (int m = 0; m < 4; ++m) _Pragma("unroll") for (int n = 0; n < 2; ++n) _Pragma("unroll") for (int k = 0; k < 2; ++k) \
        acc[ai][bj][m][n] = __builtin_amdgcn_mfma_f32_16x16x32_bf16(Bt[n][k], At[m][k], acc[ai][bj][m][n], 0, 0, 0); __builtin_amdgcn_s_setprio(0); } while (0)
#define PG8_WAIT_V(n) asm volatile("s_waitcnt vmcnt(" #n ")" ::: "memory")
#define PG8_WAIT_L(n) asm volatile("s_waitcnt lgkmcnt(" #n ")" ::: "memory")
#define PG8_BAR __builtin_amdgcn_s_barrier()
#define PG8_SCHED __builtin_amdgcn_sched_barrier(0)
    Unit cur, nxt; int ui = 0;
    if (!S.next(0, cur)) return;
    f32x4 acc[2][2][4][2];
#pragma unroll
    for (int a = 0; a < 2; ++a)
#pragma unroll
        for (int b = 0; b < 2; ++b)
#pragma unroll
            for (int m = 0; m < 4; ++m)
#pragma unroll
                for (int n = 0; n < 2; ++n) acc[a][b][m][n] = (f32x4){0.f, 0.f, 0.f, 0.f};
    bf16x8 At[4][2], B0[2][2], B1[2][2];
    const char* cA = (const char*)g.A + (size_t)cur.pm * tstepA + (size_t)cur.ks * ksoffA; const char* cB = (const char*)g.Bt + (size_t)cur.pn * tstepB + (size_t)cur.ks * ksoffB;
    PG8_STAGE(PG8_SB(0, 0), cB, voffB); PG8_STAGE(PG8_SA(0, 0), cA, voffA); PG8_STAGE(PG8_SB(0, 1), cB + hstepB, voffB); PG8_STAGE(PG8_SA(0, 1), cA + hstepA, voffA);
    if (wr == 1) PG8_BAR;
    PG8_WAIT_V(4); PG8_BAR;
    PG8_STAGE(PG8_SB(1, 0), cB + kstep, voffB); PG8_STAGE(PG8_SA(1, 0), cA + kstep, voffA); PG8_STAGE(PG8_SB(1, 1), cB + hstepB + kstep, voffB);
    PG8_WAIT_V(6); PG8_BAR;
    for (;;) {
        const bool has_next = S.next(ui + 1, nxt);
        const char* nA = has_next ? (const char*)g.A + (size_t)nxt.pm * tstepA + (size_t)nxt.ks * ksoffA : cA; const char* nB = has_next ? (const char*)g.Bt + (size_t)nxt.pn * tstepB + (size_t)nxt.ks * ksoffB : cB;
        for (int t = 0; t < nt; t += 2) {
            const bool last = (t == nt - 2);
            const char* a1 = cA + (size_t)(t >> 1) * eva + kstep;
            const char* a2 = last ? nA : cA + (size_t)((t >> 1) + 1) * eva; const char* b2 = last ? nB : cB + (size_t)(t + 2) * kstep;
            const char* a3 = a2 + kstep; const char* b3 = b2 + kstep;
            PG8_LDB(B0, 0, 0); PG8_SCHED; PG8_LDA(At, 0, 0); PG8_STAGE(PG8_SA(1, 1), a1 + hstepA, voffA);
            PG8_WAIT_L(8); PG8_BAR; PG8_WAIT_L(0); PG8_MMA(0, 0, At, B0); PG8_BAR; PG8_SCHED;
            PG8_LDB(B1, 0, 1); PG8_STAGE(PG8_SB(0, 0), b2, voffB);
            PG8_BAR; PG8_WAIT_L(0); PG8_MMA(0, 1, At, B1); PG8_BAR;
            PG8_LDA(At, 0, 1); PG8_STAGE(PG8_SA(0, 0), a2, voffA);
            PG8_BAR; PG8_WAIT_L(0); PG8_MMA(1, 0, At, B0); PG8_BAR; PG8_SCHED;
            PG8_STAGE(PG8_SB(0, 1), b2 + hstepB, voffB);
            PG8_WAIT_V(6); PG8_BAR; PG8_MMA(1, 1, At, B1); PG8_BAR;
            PG8_LDB(B0, 1, 0); PG8_SCHED; PG8_LDA(At, 1, 0); PG8_STAGE(PG8_SA(0, 1), a2 + hstepA, voffA);
            PG8_WAIT_L(8); PG8_BAR; PG8_WAIT_L(0); PG8_MMA(0, 0, At, B0); PG8_BAR; PG8_SCHED;
            PG8_LDB(B1, 1, 1); PG8_STAGE(PG8_SB(1, 0), b3, voffB);
            PG8_BAR; PG8_WAIT_L(0); PG8_MMA(0, 1, At, B1); PG8_BAR;
            PG8_LDA(At, 1, 1); PG8_STAGE(PG8_SA(1, 0), a3, voffA);
            PG8_BAR; PG8_WAIT_L(0); PG8_MMA(1, 0, At, B0); PG8_BAR; PG8_SCHED;
            PG8_STAGE(PG8_SB(1, 1), b3 + hstepB, voffB);
            PG8_WAIT_V(6); PG8_BAR; PG8_MMA(1, 1, At, B1); PG8_BAR;
        }
        E(acc, cur, wr, wc, fr, fq);
        if (!has_next) break;
#pragma unroll
        for (int a = 0; a < 2; ++a)
#pragma unroll
            for (int b = 0; b < 2; ++b)
#pragma unroll
                for (int m = 0; m < 4; ++m)
#pragma unroll
                    for (int n = 0; n < 2; ++n) acc[a][b][m][n] = (f32x4){0.f, 0.f, 0.f, 0.f};
        cur = nxt; cA = nA; cB = nB; ++ui;
    }
    PG8_WAIT_V(0);
    if (wr == 0) PG8_BAR;
    PG8_BAR;
#undef PG8_SA
#undef PG8_SB
#undef PG8_STAGE
#undef PG8_LDA
#undef PG8_LDB
#undef PG8_MMA
#undef PG8_WAIT_V
#undef PG8_WAIT_L
#undef PG8_BAR
#undef PG8_SCHED
}
}

typedef f32x4 AccT[2][2][4][2];
__device__ __forceinline__ u32x4 pack8(const f32x4 a, const f32x4 b) { u32x4 w; w.x = cvt_pk_bf16(a[0], a[1]); w.y = cvt_pk_bf16(a[2], a[3]); w.z = cvt_pk_bf16(b[0], b[1]); w.w = cvt_pk_bf16(b[2], b[3]); return w; }

struct EpiPlain {
    bf16_t* O; int ldc; bf16_t* O1 = nullptr;
    __device__ __forceinline__ void operator()(const AccT& acc, const pg8::Unit& u, int wr, int wc, int fr, int fq) const {
        bf16_t* O = u.ks ? this->O1 : this->O;
        const int row0 = u.pm * 256 + wr * 64 + fr, col0 = u.pn * 256 + wc * 32 + 8 * fq;
#pragma unroll
        for (int ai = 0; ai < 2; ++ai)
#pragma unroll
            for (int m = 0; m < 4; ++m) { bf16_t* rowp = O + (size_t)(row0 + ai * 128 + m * 16) * ldc + col0;
#pragma unroll
                for (int bj = 0; bj < 2; ++bj) *(u32x4*)(rowp + bj * 128) = pack8(acc[ai][bj][m][0], acc[ai][bj][m][1]); }
    }
};
struct EpiSwiglu {
    bf16_t* O;
    __device__ __forceinline__ void operator()(const AccT& acc, const pg8::Unit& u, int wr, int wc, int fr, int fq) const {
        const int row0 = u.pm * 256 + wr * 64 + fr, col0 = u.pn * 128 + wc * 32 + 8 * fq;
#pragma unroll
        for (int ai = 0; ai < 2; ++ai)
#pragma unroll
            for (int m = 0; m < 4; ++m) {
                f32x4 o0, o1;
#pragma unroll
                for (int j = 0; j < 4; ++j) { o0[j] = silu_f(acc[ai][0][m][0][j]) * acc[ai][1][m][0][j]; o1[j] = silu_f(acc[ai][0][m][1][j]) * acc[ai][1][m][1][j]; }
                *(u32x4*)(O + (size_t)(row0 + ai * 128 + m * 16) * DFF + col0) = pack8(o0, o1);
            }
    }
};
struct EpiMixA {
    bf16_t *PZ, *Pq, *Plff, *Plfb, *Pv, *Psg; const float* lb;
    __device__ __forceinline__ void operator()(const AccT& acc, const pg8::Unit& u, int wr, int wc, int fr, int fq) const {
        const int pn = u.pn; bf16_t* base; int ldc, colt, mode; const float* lbp = lb;
        if (pn < 4) { base = PZ; ldc = 1024; colt = pn * 256; mode = 0; }
        else { const int s = (pn - 4) >> 1; colt = ((pn - 4) & 1) * 256; ldc = 512;
            if (s == 0) { base = Pq; mode = 1; } else if (s == 1) { base = Plff; mode = 2; } else if (s == 2) { base = Plfb; mode = 2; lbp = lb + 512; } else if (s == 3) { base = Pv; mode = 0; } else { base = Psg; mode = 1; } }
        const int row0 = u.pm * 256 + wr * 64 + fr, col0 = colt + wc * 32 + 8 * fq;
        f32x4 lbv[2][2];
#pragma unroll
        for (int bj = 0; bj < 2; ++bj) { lbv[bj][0] = (f32x4){0.f, 0.f, 0.f, 0.f}; lbv[bj][1] = lbv[bj][0];
            if (mode == 2) { lbv[bj][0] = *(const f32x4*)(lbp + col0 + bj * 128); lbv[bj][1] = *(const f32x4*)(lbp + col0 + bj * 128 + 4); } }
#pragma unroll
        for (int ai = 0; ai < 2; ++ai)
#pragma unroll
            for (int m = 0; m < 4; ++m) { bf16_t* rowp = base + (size_t)(row0 + ai * 128 + m * 16) * ldc + col0;
#pragma unroll
                for (int bj = 0; bj < 2; ++bj) { f32x4 v0 = acc[ai][bj][m][0], v1 = acc[ai][bj][m][1];
                    if (mode == 1) {
#pragma unroll
                        for (int j = 0; j < 4; ++j) { v0[j] = silu_f(v0[j]); v1[j] = silu_f(v1[j]); } }
                    else if (mode == 2) {
#pragma unroll
                        for (int j = 0; j < 4; ++j) { const float l0 = lbv[bj][0][j], l1 = lbv[bj][1][j];
                            v0[j] = __logf(l0 + (1.f - l0) * sigm_f(v0[j])); v1[j] = __logf(l1 + (1.f - l1) * sigm_f(v1[j])); } }
                    *(u32x4*)(rowp + bj * 128) = pack8(v0, v1); } }
    }
};
struct EpiGate {
    bf16_t *Ga, *Gb;
    __device__ __forceinline__ void operator()(const AccT& acc, const pg8::Unit& u, int wr, int wc, int fr, int fq) const {
        bf16_t* base = u.pn < 4 ? Ga : Gb;
        const int row0 = u.pm * 256 + wr * 64 + fr, col0 = (u.pn & 3) * 256 + wc * 32 + 8 * fq;
#pragma unroll
        for (int ai = 0; ai < 2; ++ai)
#pragma unroll
            for (int m = 0; m < 4; ++m) { bf16_t* rowp = base + (size_t)(row0 + ai * 128 + m * 16) * 1024 + col0;
#pragma unroll
                for (int bj = 0; bj < 2; ++bj) { f32x4 v0 = acc[ai][bj][m][0], v1 = acc[ai][bj][m][1];
#pragma unroll
                    for (int j = 0; j < 4; ++j) { v0[j] = sigm_f(v0[j]); v1[j] = sigm_f(v1[j]); }
                    *(u32x4*)(rowp + bj * 128) = pack8(v0, v1); } }
    }
};
struct EpiGateMerge {
    const bf16_t *BA, *BB; bf16_t* O;
    __device__ __forceinline__ void operator()(const AccT& acc, const pg8::Unit& u, int wr, int wc, int fr, int fq) const {
        const int row0 = u.pm * 256 + wr * 64 + fr, col0 = u.pn * 128 + wc * 32 + 8 * fq;
#pragma unroll
        for (int ai = 0; ai < 2; ++ai) {
            u32x4 pa[4], pb[4];
#pragma unroll
            for (int m = 0; m < 4; ++m) { const size_t ro = (size_t)(row0 + ai * 128 + m * 16) * 1024 + col0;
                pa[m] = *(const u32x4*)(BA + ro); pb[m] = *(const u32x4*)(BB + ro); }
#pragma unroll
            for (int m = 0; m < 4; ++m) { const size_t ro = (size_t)(row0 + ai * 128 + m * 16) * 1024 + col0;
                const u32x4 a = pa[m], b = pb[m];
                const f32x4 a0 = (f32x4){bflo(a.x), bfhi(a.x), bflo(a.y), bfhi(a.y)}, a1 = (f32x4){bflo(a.z), bfhi(a.z), bflo(a.w), bfhi(a.w)};
                const f32x4 b0 = (f32x4){bflo(b.x), bfhi(b.x), bflo(b.y), bfhi(b.y)}, b1 = (f32x4){bflo(b.z), bfhi(b.z), bflo(b.w), bfhi(b.w)};
                f32x4 o0, o1;
#pragma unroll
                for (int j = 0; j < 4; ++j) { o0[j] = sigm_f(acc[ai][0][m][0][j]) * a0[j] + sigm_f(acc[ai][1][m][0][j]) * b0[j];
                    o1[j] = sigm_f(acc[ai][0][m][1][j]) * a1[j] + sigm_f(acc[ai][1][m][1][j]) * b1[j]; }
                *(u32x4*)(O + ro) = pack8(o0, o1); }
        }
    }
};
template <int MODE> struct EpiMerge {
    bf16_t *Ga; const bf16_t* Gb;
    __device__ __forceinline__ void operator()(const AccT& acc, const pg8::Unit& u, int wr, int wc, int fr, int fq) const {
        const int row0 = u.pm * 256 + wr * 64 + fr, col0 = u.pn * 256 + wc * 32 + 8 * fq;
#pragma unroll
        for (int ai = 0; ai < 2; ++ai)
#pragma unroll
            for (int m = 0; m < 4; ++m) { const size_t ro = (size_t)(row0 + ai * 128 + m * 16) * 1024 + col0;
#pragma unroll
                for (int bj = 0; bj < 2; ++bj) { const f32x4 v0 = acc[ai][bj][m][0], v1 = acc[ai][bj][m][1];
                    const u32x4 ga = *(const u32x4*)(Ga + ro + bj * 128);
                    f32x4 o0, o1;
                    if (MODE == 0) {
                        o0 = (f32x4){bflo(ga.x) * v0[0], bfhi(ga.x) * v0[1], bflo(ga.y) * v0[2], bfhi(ga.y) * v0[3]};
                        o1 = (f32x4){bflo(ga.z) * v1[0], bfhi(ga.z) * v1[1], bflo(ga.w) * v1[2], bfhi(ga.w) * v1[3]};
                    } else {
                        const u32x4 gb = *(const u32x4*)(Gb + ro + bj * 128);
                        o0 = (f32x4){bflo(ga.x) + bflo(gb.x) * v0[0], bfhi(ga.x) + bfhi(gb.x) * v0[1], bflo(ga.y) + bflo(gb.y) * v0[2], bfhi(ga.y) + bfhi(gb.y) * v0[3]};
                        o1 = (f32x4){bflo(ga.z) + bflo(gb.z) * v1[0], bfhi(ga.z) + bfhi(gb.z) * v1[1], bflo(ga.w) + bflo(gb.w) * v1[2], bfhi(ga.w) + bfhi(gb.w) * v1[3]};
                    }
                    *(u32x4*)(Ga + ro + bj * 128) = pack8(o0, o1); } }
    }
};

template <class Epi>
__device__ __forceinline__ void run_gemm(LAS unsigned char* lds, const bf16_t* A, const bf16_t* Bt, int N, int K, const Epi& E, int ksplit = 1, int lda = 0, int ldb = 0, int eva = 256) {
    pg8::Gemm g; g.A = A; g.Bt = Bt; g.M = T_ALL; g.N = N; g.K = K / ksplit; g.lda = lda ? lda : K; g.ldb = ldb ? ldb : K; g.eva = eva;
    pg8::StaticOrder S; S.init(T_ALL, N, ksplit, gridDim.x, blockIdx.x);
    pg8::gemm_phase<Epi>(lds, g, S, E);
}

struct ConvJob { const float* src; bf16_t* dst; int ldsrc, ldd; };
__device__ __forceinline__ ConvJob conv_decode(const Params& p, int it) {
    unsigned char* ws = p.ws; ConvJob j; int t = it; int k0, c0, n0, kd0;
    if (t < 2816) {
        const int l = t / 1408; t -= l * 1408; const int ntile = t >> 4, kt = t & 15; n0 = ntile * 64;
        const int blk = n0 >> 8, within = n0 & 255, bj = within >> 7; c0 = bj * DFF + blk * 128 + (within & 127); k0 = kt * 64; kd0 = k0;
        j.src = p.in[9] + (size_t)l * 1024 * 5632; j.ldsrc = 5632; j.dst = (bf16_t*)(ws + (l ? WS_WIN1 : WS_WIN0)); j.ldd = 1024;
    } else if ((t -= 2816) < 1408) {
        const int l = t / 704; t -= l * 704; const int ntile = t / 44, kt = t % 44; n0 = ntile * 64; c0 = n0; k0 = kt * 64; kd0 = k0;
        j.src = p.in[10] + (size_t)l * DFF * 1024; j.ldsrc = 1024; j.dst = (bf16_t*)(ws + (l ? WS_WOUT1 : WS_WOUT0)); j.ldd = DFF;
    } else if ((t -= 1408) < 640) {
        const int ntile = t >> 4, kt = t & 15; n0 = 1024 + ntile * 64; c0 = 512 + ntile * 64; k0 = kt * 64; kd0 = k0;
        j.src = p.in[11]; j.ldsrc = 5120; j.dst = (bf16_t*)(ws + WS_WMIXA); j.ldd = 1024;
    } else if ((t -= 640) < 512) {
        const int ntile = t >> 4, kt = t & 15; n0 = ntile * 64;
        const int blk = n0 >> 8, within = n0 & 255, bj = within >> 7; c0 = 3072 + bj * 1024 + blk * 128 + (within & 127); k0 = kt * 64; kd0 = k0;
        j.src = p.in[11]; j.ldsrc = 5120; j.dst = (bf16_t*)(ws + WS_WGATE); j.ldd = 1024;
    } else if ((t -= 512) < 128) {
        const int ntile = t >> 3, kt = t & 7; n0 = ntile * 64; c0 = n0; k0 = kt * 64; kd0 = k0;
        j.src = p.in[12]; j.ldsrc = 1024; j.dst = (bf16_t*)(ws + WS_WFOUR); j.ldd = 512;
    } else if ((t -= 128) < 128) {
        const int ntile = t >> 3, kt = t & 7; n0 = ntile * 64; c0 = n0; k0 = kt * 64; kd0 = k0;
        j.src = p.in[14]; j.ldsrc = 1024; j.dst = (bf16_t*)(ws + WS_WHGRN); j.ldd = 512;
    } else { t -= 128;
        const int ntile = t >> 4, kt = t & 15; n0 = ntile * 64; c0 = n0; k0 = kt * 64; kd0 = k0;
        j.src = p.in[15]; j.ldsrc = 1024; j.dst = (bf16_t*)(ws + WS_WO); j.ldd = 1024;
    }
    j.src += (size_t)k0 * j.ldsrc + c0; j.dst += (size_t)n0 * j.ldd + kd0;
    return j;
}

__device__ __forceinline__ void fold_items(const Params& p, LAS unsigned char* lds, int first, int stride) {
    const int tid = threadIdx.x; unsigned char* ws = p.ws;
    {
        LAS float* Wl = (LAS float*)lds; LAS float* ct = Wl + 32 * 128; LAS float* st = ct + 128;
        const float* win = p.in[11]; bf16_t* wmix = (bf16_t*)(ws + WS_WMIXA);
        for (int item = first; item < 128; item += stride) {
            const int g = item >> 5, k0 = (item & 31) * 32;
            for (int i = tid; i < 32 * 32; i += 512) { const int kk = i >> 5, c4 = i & 31; const f32x4 v = *(const f32x4*)(win + (size_t)(k0 + kk) * 5120 + g * 128 + 4 * c4);
#pragma unroll
                for (int e = 0; e < 4; ++e) Wl[kk * 128 + 4 * c4 + e] = v[e]; }
            if (tid < 128) { const float ph = (float)tid * (1.f / 128.f); ct[tid] = __builtin_amdgcn_cosf(ph) * 0.08838834764831845f; st[tid] = __builtin_amdgcn_sinf(ph) * 0.08838834764831845f; }
            __syncthreads();
            const int np = tid & 255, part = np >> 7, chp = np & 127, kh = tid >> 8;
            LAS float* tw = part ? st : ct;
            float acc[16];
#pragma unroll
            for (int e = 0; e < 16; ++e) acc[e] = 0.f;
            for (int ch = 0; ch < 128; ++ch) { const float t = tw[(ch * chp) & 127];
#pragma unroll
                for (int e = 0; e < 16; ++e) acc[e] += Wl[(16 * kh + e) * 128 + ch] * t; }
            bf16_t* d = wmix + (size_t)(g * 256 + np) * 1024 + k0 + 16 * kh;
            *(u32x4*)d = pack8((f32x4){acc[0], acc[1], acc[2], acc[3]}, (f32x4){acc[4], acc[5], acc[6], acc[7]});
            *(u32x4*)(d + 8) = pack8((f32x4){acc[8], acc[9], acc[10], acc[11]}, (f32x4){acc[12], acc[13], acc[14], acc[15]});
            __syncthreads();
        }
    }
}

template <bool EARLY>
__device__ __forceinline__ void conv_tiles(const Params& p, LAS unsigned char* lds, int first, int stride) {
    const int tid = threadIdx.x;
    constexpr int NT = EARLY ? 2112 : 3776;
    auto tmap = [](int i) { return EARLY ? (i < 1408 ? i : 2816 + (i - 1408)) : (i < 1408 ? 1408 + i : (i < 2112 ? 3520 + (i - 1408) : 4224 + (i - 2112))); };
    {
        LAS float* tile = (LAS float*)lds;
        const int c4 = tid & 15, kk = tid >> 4, nn = tid >> 3, ko = tid & 7;
        int it = first;
        f32x4 v0 = (f32x4){0.f, 0.f, 0.f, 0.f}, v1 = v0; ConvJob cur{};
        if (it < NT) { cur = conv_decode(p, tmap(it)); v0 = *(const f32x4*)(cur.src + (size_t)kk * cur.ldsrc + 4 * c4); v1 = *(const f32x4*)(cur.src + (size_t)(kk + 32) * cur.ldsrc + 4 * c4); }
        while (it < NT) {
            const int itn = it + stride;
#pragma unroll
            for (int e = 0; e < 4; ++e) { tile[kk * 65 + 4 * c4 + e] = v0[e]; tile[(kk + 32) * 65 + 4 * c4 + e] = v1[e]; }
            ConvJob nxt{};
            if (itn < NT) { nxt = conv_decode(p, tmap(itn)); v0 = *(const f32x4*)(nxt.src + (size_t)kk * nxt.ldsrc + 4 * c4); v1 = *(const f32x4*)(nxt.src + (size_t)(kk + 32) * nxt.ldsrc + 4 * c4); }
            asm volatile("s_waitcnt lgkmcnt(0)" ::: "memory"); __builtin_amdgcn_s_barrier(); asm volatile("" ::: "memory");
            { f32x4 a, b;
#pragma unroll
                for (int e = 0; e < 4; ++e) { a[e] = tile[(ko * 8 + e) * 65 + nn]; b[e] = tile[(ko * 8 + 4 + e) * 65 + nn]; }
                *(u32x4*)(cur.dst + (size_t)nn * cur.ldd + ko * 8) = pack8(a, b); }
            asm volatile("s_waitcnt lgkmcnt(0)" ::: "memory"); __builtin_amdgcn_s_barrier(); asm volatile("" ::: "memory");
            cur = nxt; it = itn;
        }
    }
}

__device__ __forceinline__ void phase0(const Params& p, LAS unsigned char* lds) {
    const int tid = threadIdx.x;
    unsigned char* ws = p.ws;
    {
        LAS float* sc = (LAS float*)lds; LAS float* red = sc + 9216;
        const float* cvec = p.in[3]; const float* cctx = p.in[4]; const float* wmod = p.in[5]; const float* bmod = p.in[6];
        float* mod = (float*)(ws + WS_MOD);
        for (int i = tid; i < 9216; i += 512) { const int c = i >> 10, k = i & 1023; const float x = c == 0 ? cctx[k] : cvec[(c - 1) * 1024 + k]; sc[i] = silu_f(x); }
        __syncthreads();
        for (int item = blockIdx.x; item < 256; item += gridDim.x) {
            const int n0 = item * 36, cq = tid % 9, kg = tid / 9;
            float acc[9][4];
#pragma unroll
            for (int c = 0; c < 9; ++c)
#pragma unroll
                for (int e = 0; e < 4; ++e) acc[c][e] = 0.f;
            if (kg < 56) {
                for (int k0 = kg; k0 < 1024; k0 += 5 * 56) {
                    f32x4 w[5];
#pragma unroll
                    for (int u = 0; u < 5; ++u) { const int k = k0 + 56 * u; w[u] = (k < 1024) ? *(const f32x4*)(wmod + (size_t)k * 9216 + n0 + 4 * cq) : (f32x4){0.f, 0.f, 0.f, 0.f}; }
#pragma unroll
                    for (int u = 0; u < 5; ++u) { const int k = (k0 + 56 * u < 1024) ? k0 + 56 * u : 0;
#pragma unroll
                        for (int c = 0; c < 9; ++c) { const float sv = sc[c * 1024 + k];
#pragma unroll
                            for (int e = 0; e < 4; ++e) acc[c][e] += sv * w[u][e]; } } }
#pragma unroll
                for (int c = 0; c < 9; ++c)
#pragma unroll
                    for (int e = 0; e < 4; ++e) red[(kg * 9 + cq) * 36 + c * 4 + e] = acc[c][e];
            }
            __syncthreads();
            if (tid < 324) { const int cq2 = tid / 36, rem = tid % 36, c = rem >> 2, e = rem & 3; float s = 0.f;
                for (int g = 0; g < 56; ++g) s += red[(g * 9 + cq2) * 36 + rem];
                mod[c * 9216 + n0 + 4 * cq2 + e] = s + bmod[n0 + 4 * cq2 + e]; }
            __syncthreads();
        }
    }
    {
        const int gt = blockIdx.x * 512 + tid, gs = gridDim.x * 512;
        const float* lbl = p.in[16]; float* lb = (float*)(ws + WS_LB);
        for (int i = gt; i < 1024; i += gs) lb[i] = 1.f / (1.f + __expf(lbl[1024 + i] - lbl[i]));
        bf16_t* ttc = (bf16_t*)(ws + WS_TTC); bf16_t* tt2 = (bf16_t*)(ws + WS_TT2); bf16_t* tt3 = (bf16_t*)(ws + WS_TT3);
        for (int i = gt; i < 256 * 512; i += gs) { const int n = i >> 9, kk = i & 511, pos = kk & 255; const float ph = (float)((n * pos) & 255) * (1.f / 256.f);
            const float v = (kk < 256 ? __builtin_amdgcn_cosf(ph) : -__builtin_amdgcn_sinf(ph)) * (1.f / 16.f); ttc[i] = f2bf(v); }
        for (int i = gt; i < 128 * 128; i += gs) { const int n = i >> 7, kk = i & 127, pos = kk & 63, np = n & 63; const float ph = (float)((np * pos) & 63) * (1.f / 64.f);
            const float cs = __builtin_amdgcn_cosf(ph), sn = __builtin_amdgcn_sinf(ph);
            const float v = (n < 64) ? (kk < 64 ? cs : -sn) : (kk < 64 ? sn : cs); tt2[i] = f2bf(v * 0.125f); }
        for (int i = gt; i < 64 * 128; i += gs) { const int n = i >> 7, kk = i & 127, pos = kk & 63; const float ph = (float)((n * pos) & 63) * (1.f / 64.f);
            const float v = (kk < 64 ? __builtin_amdgcn_cosf(ph) : -__builtin_amdgcn_sinf(ph)) * 0.125f; tt3[i] = f2bf(v); }
    }
    fold_items(p, lds, (int)blockIdx.x, (int)gridDim.x);
    conv_tiles<true>(p, lds, (int)blockIdx.x, (int)gridDim.x);
}

template <int MODE>
__device__ __forceinline__ void seam_phase(const Params& p) {
    constexpr int NR = 2;
    const int wid = threadIdx.x >> 6, lane = threadIdx.x & 63;
    const float* mod = (const float*)(p.ws + WS_MOD);
    bf16_t* HF = (bf16_t*)(p.ws + WS_HF); const bf16_t* F2 = (const bf16_t*)(p.ws + WS_S);
    bf16_t* XB1 = (bf16_t*)p.out; bf16_t* XB2 = (bf16_t*)(p.ws + WS_R + (size_t)T_ALL * DFF * 2);
    const float* npre = p.in[7]; const float* npost = p.in[8];
    constexpr int pi = MODE >= 1 ? MODE - 1 : 0, gi = MODE >= 1 ? 2 + 3 * (MODE - 1) : 0, pj = MODE <= 2 ? MODE : 0;
    constexpr float wgt = (MODE == 2) ? 1.f : 0.5f;
    const int nwaves = gridDim.x * 8, gw = blockIdx.x * 8 + wid;
    const int rpw = ((T_ALL + nwaves - 1) / nwaves + NR - 1) / NR * NR;
    const int rbeg = gw * rpw, rend = (rbeg + rpw < T_ALL) ? rbeg + rpw : T_ALL;
    f32x4 vnpost[4], vnpre[4], vg[4], vsh[4], vsc[4];
#pragma unroll
    for (int i = 0; i < 4; ++i) { const int col = 256 * i + 4 * lane;
        vnpost[i] = (MODE >= 1) ? *(const f32x4*)(npost + pi * 1024 + col) : (f32x4){0.f, 0.f, 0.f, 0.f};
        vnpre[i] = (MODE <= 2) ? *(const f32x4*)(npre + pj * 1024 + col) : (f32x4){0.f, 0.f, 0.f, 0.f};
        vg[i] = vsh[i] = vsc[i] = (f32x4){0.f, 0.f, 0.f, 0.f}; }
    int cur = -1;
    for (int row0 = rbeg; row0 < rend; row0 += NR) {
        f32x4 x[NR][4]; f32x4 f[NR][4];
#pragma unroll
        for (int r = 0; r < NR; ++r) { const int row = row0 + r;
            if (MODE <= 1) { const float* xsrc = row < T_CTX ? p.in[0] + (size_t)row * 1024 : p.in[1] + (size_t)(row - T_CTX) * 1024;
#pragma unroll
                for (int i = 0; i < 4; ++i) x[r][i] = *(const f32x4*)(xsrc + 256 * i + 4 * lane); }
            else { const bf16_t* xb = (MODE == 2 ? XB1 : XB2) + (size_t)row * 1024;
#pragma unroll
                for (int i = 0; i < 4; ++i) { const u32x2 w = *(const u32x2*)(xb + 256 * i + 4 * lane); x[r][i] = (f32x4){bflo(w.x), bfhi(w.x), bflo(w.y), bfhi(w.y)}; } }
            if (MODE >= 1) {
#pragma unroll
                for (int i = 0; i < 4; ++i) { const u32x2 w = *(const u32x2*)(HF + (size_t)row * 1024 + 256 * i + 4 * lane); f[r][i] = (f32x4){bflo(w.x), bfhi(w.x), bflo(w.y), bfhi(w.y)};
                    if (MODE != 2 && FFN_KSPLIT == 2) { const u32x2 w2 = *(const u32x2*)(F2 + (size_t)row * 1024 + 256 * i + 4 * lane);
                        f[r][i] += (f32x4){bflo(w2.x), bfhi(w2.x), bflo(w2.y), bfhi(w2.y)}; } } }
        }
        const int cidx = row0 < T_CTX ? 0 : 1 + ((row0 - T_CTX) >> 12);
        if (cidx != cur) { cur = cidx; const float* modc = mod + cidx * 9216;
#pragma unroll
            for (int i = 0; i < 4; ++i) { const int col = 256 * i + 4 * lane;
                if (MODE >= 1) vg[i] = *(const f32x4*)(modc + gi * 1024 + col);
                if (MODE <= 2) { vsh[i] = *(const f32x4*)(modc + (3 * pj) * 1024 + col); vsc[i] = *(const f32x4*)(modc + (3 * pj + 1) * 1024 + col); } } }
        if (MODE >= 1) {
            float rF[NR];
#pragma unroll
            for (int r = 0; r < NR; ++r) { float ss = 0.f;
#pragma unroll
                for (int i = 0; i < 4; ++i)
#pragma unroll
                    for (int e = 0; e < 4; ++e) ss += f[r][i][e] * f[r][i][e];
                ss = wave_sum(ss); rF[r] = rsqrtf(ss * (1.f / 1024.f) + EPS); }
#pragma unroll
            for (int i = 0; i < 4; ++i) { const int col = 256 * i + 4 * lane;
#pragma unroll
                for (int r = 0; r < NR; ++r) {
#pragma unroll
                    for (int e = 0; e < 4; ++e) x[r][i][e] += wgt * vg[i][e] * (f[r][i][e] * rF[r] * vnpost[i][e]);
                    if (MODE == 3) *(f32x4*)(p.out + (size_t)(row0 + r) * 1024 + col) = x[r][i];
                    else { u32x2 w; w.x = cvt_pk_bf16(x[r][i][0], x[r][i][1]); w.y = cvt_pk_bf16(x[r][i][2], x[r][i][3]);
                        *(u32x2*)((MODE == 1 ? XB1 : XB2) + (size_t)(row0 + r) * 1024 + col) = w;
                        x[r][i] = (f32x4){bflo(w.x), bfhi(w.x), bflo(w.y), bfhi(w.y)}; } } }
        }
        if (MODE <= 2) {
            float rinv[NR];
#pragma unroll
            for (int r = 0; r < NR; ++r) { float ss = 0.f;
#pragma unroll
                for (int i = 0; i < 4; ++i)
#pragma unroll
                    for (int e = 0; e < 4; ++e) ss += x[r][i][e] * x[r][i][e];
                ss = wave_sum(ss); rinv[r] = rsqrtf(ss * (1.f / 1024.f) + EPS); }
#pragma unroll
            for (int i = 0; i < 4; ++i) { const int col = 256 * i + 4 * lane;
#pragma unroll
                for (int r = 0; r < NR; ++r) { f32x4 h;
#pragma unroll
                    for (int e = 0; e < 4; ++e) h[e] = x[r][i][e] * rinv[r] * vnpre[i][e] * (1.f + vsc[i][e]) + vsh[i][e];
                    u32x2 w; w.x = cvt_pk_bf16(h[0], h[1]); w.y = cvt_pk_bf16(h[2], h[3]);
                    *(u32x2*)(HF + (size_t)(row0 + r) * 1024 + col) = w; } }
        }
    }
}

template <int CH, int NPOS, int NOUT, int MODE>
__device__ __forceinline__ void fourier_item(LAS unsigned char* lds, bf16_t* PZ, int tok0, int tstride, int colbase, const bf16_t* TT) {
    constexpr int LDX = 2 * NPOS + 8, K = 2 * NPOS, MT = CH / 16, NCHUNK = NPOS * 2 * (CH / 8);
    const int tid = threadIdx.x, wid = tid >> 6, lane = tid & 63, fr = lane & 15, fq = lane >> 4;
    LAS bf16_t* X = (LAS bf16_t*)lds;
    for (int q = tid; q < NCHUNK / 2; q += 512) {
        const int pp = q % (NPOS / 2), rest = q / (NPOS / 2), oct = rest % (CH / 8), part = rest / (CH / 8), pos = 2 * pp;
        const bf16_t* g0 = PZ + (size_t)(tok0 + pos * tstride) * 1024 + colbase + part * 128 + oct * 8;
        const u32x4 v0 = *(const u32x4*)g0, v1 = *(const u32x4*)(g0 + (size_t)tstride * 1024);
        constexpr int LW = LDX / 2;
        LAS unsigned* d = (LAS unsigned*)(X + (oct * 8) * LDX + part * NPOS + pos);
        d[0 * LW] = (v0.x & 0xffffu) | (v1.x << 16); d[1 * LW] = (v0.x >> 16) | (v1.x & 0xffff0000u);
        d[2 * LW] = (v0.y & 0xffffu) | (v1.y << 16); d[3 * LW] = (v0.y >> 16) | (v1.y & 0xffff0000u);
        d[4 * LW] = (v0.z & 0xffffu) | (v1.z << 16); d[5 * LW] = (v0.z >> 16) | (v1.z & 0xffff0000u);
        d[6 * LW] = (v0.w & 0xffffu) | (v1.w << 16); d[7 * LW] = (v0.w >> 16) | (v1.w & 0xffff0000u);
    }
    __syncthreads();
    for (int nt = wid; nt < NOUT / 16; nt += 8) {
        f32x4 acc[MT];
#pragma unroll
        for (int mt = 0; mt < MT; ++mt) acc[mt] = (f32x4){0.f, 0.f, 0.f, 0.f};
        const bf16_t* tp = TT + (size_t)(16 * nt + fr) * K + 8 * fq;
#pragma unroll 4
        for (int ks = 0; ks < K / 32; ++ks) {
            const bf16x8 b = *(const bf16x8*)(tp + 32 * ks);
#pragma unroll
            for (int mt = 0; mt < MT; ++mt) { const bf16x8 a = *(const LAS bf16x8*)(X + (16 * mt + fr) * LDX + 32 * ks + 8 * fq);
                acc[mt] = __builtin_amdgcn_mfma_f32_16x16x32_bf16(a, b, acc[mt], 0, 0, 0); }
        }
        const int n = 16 * nt + fr;
        int token, col;
        if (MODE == 0) { token = tok0 + n; col = colbase; }
        else if (MODE == 1) { token = tok0 + (n & 63); col = colbase + (n >> 6) * 128; }
        else { token = tok0 + n * 64; col = colbase; }
        bf16_t* op = PZ + (size_t)token * 1024 + col + 4 * fq;
#pragma unroll
        for (int mt = 0; mt < MT; ++mt) { u32x2 w; w.x = cvt_pk_bf16(acc[mt][0], acc[mt][1]); w.y = cvt_pk_bf16(acc[mt][2], acc[mt][3]); *(u32x2*)(op + 16 * mt) = w; }
    }
    __syncthreads();
}

constexpr int H_LF = 0, H_B = 16384, H_QS = 32768, H_KS = 41472, H_KT = 50176, H_VT = 60672, H_AS = 71168, H_ST = 73728, H_OT = 108544, H_ER = 125440, H_EL = 125952;
__device__ __forceinline__ int tro(int r) { return 40 * r + 8 * (r >> 3); }
#define LDS_BAR() do { asm volatile("s_waitcnt lgkmcnt(0)" ::: "memory"); __builtin_amdgcn_s_barrier(); asm volatile("" ::: "memory"); } while (0)
struct HgrnPtrs { bf16_t* Pq; const bf16_t *Plff, *Plfb, *Pv, *Psg; const float* gain; };

template <bool OUT>
__device__ __forceinline__ void hgrn_pass(LAS unsigned char* lds, const HgrnPtrs& hp, int tokbase, int h, int dir, f32x4 (&Sm)[8], float* stash, float& dsum) {
    const int tid = threadIdx.x, wid = tid >> 6, lane = tid & 63, fr = lane & 15, fq = lane >> 4;
    const int t_ld = tid >> 4, oc = tid & 15;
    LAS float* LF = (LAS float*)(lds + H_LF); LAS float* Bc = (LAS float*)(lds + H_B);
    LAS bf16_t* QS = (LAS bf16_t*)(lds + H_QS); LAS bf16_t* KS = (LAS bf16_t*)(lds + H_KS);
    LAS bf16_t* KT = (LAS bf16_t*)(lds + H_KT); LAS bf16_t* VT = (LAS bf16_t*)(lds + H_VT);
    LAS bf16_t* AS = (LAS bf16_t*)(lds + H_AS); LAS bf16_t* ST = (LAS bf16_t*)(lds + H_ST);
    LAS float* OT = (LAS float*)(lds + H_OT);
    LAS float* ER = (LAS float*)(lds + H_ER); LAS float* EL = (LAS float*)(lds + H_EL);
    const bf16_t* Plf = dir ? hp.Plfb : hp.Plff;
    const int mid = dir ? 16 : 15, last = dir ? 0 : 31;
    u32x4 qv_n = (u32x4){0u, 0u, 0u, 0u}, lv_n, vv_n, sg_n = (u32x4){0u, 0u, 0u, 0u};
    { const size_t ro = (size_t)(tokbase + 32 * (dir ? 7 : 0) + t_ld) * 512 + h * 128 + oc * 8;
        if (OUT) qv_n = *(const u32x4*)(hp.Pq + ro);
        lv_n = *(const u32x4*)(Plf + ro); vv_n = *(const u32x4*)(hp.Pv + ro);
        if (OUT && dir) sg_n = *(const u32x4*)(hp.Psg + ro); }
#pragma unroll 1
    for (int cc = 0; cc < 8; ++cc) {
        const int c = dir ? 7 - cc : cc;
        const size_t rowoff = (size_t)(tokbase + 32 * c + t_ld) * 512 + h * 128 + oc * 8;
        const u32x4 qv = qv_n, lv = lv_n, vv = vv_n, sg = sg_n;
        if (cc < 7) { const size_t ro = (size_t)(tokbase + 32 * (dir ? 6 - cc : cc + 1) + t_ld) * 512 + h * 128 + oc * 8;
            if (OUT) qv_n = *(const u32x4*)(hp.Pq + ro);
            lv_n = *(const u32x4*)(Plf + ro); vv_n = *(const u32x4*)(hp.Pv + ro);
            if (OUT && dir) sg_n = *(const u32x4*)(hp.Psg + ro); }
        float lf[8] = {bflo(lv.x), bfhi(lv.x), bflo(lv.y), bfhi(lv.y), bflo(lv.z), bfhi(lv.z), bflo(lv.w), bfhi(lv.w)};
        *(LAS f32x4*)(LF + t_ld * 128 + oc * 8) = (f32x4){lf[0], lf[1], lf[2], lf[3]};
        *(LAS f32x4*)(LF + t_ld * 128 + oc * 8 + 4) = (f32x4){lf[4], lf[5], lf[6], lf[7]};
        { LAS bf16_t* d = VT + tro(oc * 8) + t_ld;
            d[0] = (bf16_t)(vv.x & 0xffffu); d[40] = (bf16_t)(vv.x >> 16); d[80] = (bf16_t)(vv.y & 0xffffu); d[120] = (bf16_t)(vv.y >> 16);
            d[160] = (bf16_t)(vv.z & 0xffffu); d[200] = (bf16_t)(vv.z >> 16); d[240] = (bf16_t)(vv.w & 0xffffu); d[280] = (bf16_t)(vv.w >> 16); }
        LDS_BAR();
        {
            const int k = tid & 127, part = tid >> 7; float pre = 0.f;
            if (!dir) { for (int t = 0; t < 8 * part; ++t) pre += LF[t * 128 + k];
#pragma unroll
                for (int e = 0; e < 8; ++e) { const int t = 8 * part + e; pre += LF[t * 128 + k]; Bc[t * 128 + k] = pre; } }
            else { for (int t = 31; t >= 8 * (part + 1); --t) pre += LF[t * 128 + k];
#pragma unroll
                for (int e = 7; e >= 0; --e) { const int t = 8 * part + e; pre += LF[t * 128 + k]; Bc[t * 128 + k] = pre; } }
            if (OUT && part == (dir ? 2 : 1)) ER[k] = __expf(pre);
            if (part == (dir ? 0 : 3)) EL[k] = __expf(pre);
        }
        LDS_BAR();
        {
            const f32x4 b0 = *(const LAS f32x4*)(Bc + t_ld * 128 + oc * 8), b1 = *(const LAS f32x4*)(Bc + t_ld * 128 + oc * 8 + 4);
            const f32x4 r0 = *(const LAS f32x4*)(Bc + mid * 128 + oc * 8), r1 = *(const LAS f32x4*)(Bc + mid * 128 + oc * 8 + 4);
            const f32x4 l0 = *(const LAS f32x4*)(Bc + last * 128 + oc * 8), l1 = *(const LAS f32x4*)(Bc + last * 128 + oc * 8 + 4);
            const float q8[8] = {bflo(qv.x), bfhi(qv.x), bflo(qv.y), bfhi(qv.y), bflo(qv.z), bfhi(qv.z), bflo(qv.w), bfhi(qv.w)};
            float qs[8], ks[8], kh[8];
#pragma unroll
            for (int j = 0; j < 8; ++j) { const float b = j < 4 ? b0[j & 3] : b1[j & 3], r = j < 4 ? r0[j & 3] : r1[j & 3], bl = j < 4 ? l0[j & 3] : l1[j & 3];
                const float kk = 1.f - __expf(lf[j]);
                if (OUT) { qs[j] = q8[j] * __expf(b - r); ks[j] = kk * __expf(r - b); }
                kh[j] = kk * __expf(bl - b); }
            if (OUT) {
                *(LAS u32x4*)(QS + t_ld * 136 + oc * 8) = pack8((f32x4){qs[0], qs[1], qs[2], qs[3]}, (f32x4){qs[4], qs[5], qs[6], qs[7]});
                *(LAS u32x4*)(KS + t_ld * 136 + oc * 8) = pack8((f32x4){ks[0], ks[1], ks[2], ks[3]}, (f32x4){ks[4], ks[5], ks[6], ks[7]});
            }
            LAS bf16_t* d = KT + tro(oc * 8) + t_ld;
#pragma unroll
            for (int j = 0; j < 8; ++j) d[j * 40] = f2bf(kh[j]);
            if (OUT) {
#pragma unroll
                for (int kt = 0; kt < 8; ++kt) { const f32x4 r4 = *(const LAS f32x4*)(ER + 16 * kt + 4 * fq);
                    u32x2 w; w.x = cvt_pk_bf16(Sm[kt][0] * r4[0], Sm[kt][1] * r4[1]); w.y = cvt_pk_bf16(Sm[kt][2] * r4[2], Sm[kt][3] * r4[3]);
                    *(LAS u32x2*)(ST + (16 * wid + fr) * 136 + 16 * kt + 4 * fq) = w; }
            }
        }
        LDS_BAR();
        f32x4 ao[2] = {(f32x4){0.f, 0.f, 0.f, 0.f}, (f32x4){0.f, 0.f, 0.f, 0.f}};
        if (OUT) {
#pragma unroll
            for (int ks = 0; ks < 4; ++ks) { const bf16x8 b = *(const LAS bf16x8*)(ST + (16 * wid + fr) * 136 + 32 * ks + 8 * fq);
#pragma unroll
                for (int ti = 0; ti < 2; ++ti) { const bf16x8 a = *(const LAS bf16x8*)(QS + (16 * ti + fr) * 136 + 32 * ks + 8 * fq);
                    ao[ti] = __builtin_amdgcn_mfma_f32_16x16x32_bf16(a, b, ao[ti], 0, 0, 0); } }
            if (wid < 4) { const int ti = wid >> 1, si = wid & 1; f32x4 aa = (f32x4){0.f, 0.f, 0.f, 0.f};
#pragma unroll
                for (int ks = 0; ks < 4; ++ks) { const bf16x8 a = *(const LAS bf16x8*)(QS + (16 * ti + fr) * 136 + 32 * ks + 8 * fq);
                    const bf16x8 b = *(const LAS bf16x8*)(KS + (16 * si + fr) * 136 + 32 * ks + 8 * fq);
                    aa = __builtin_amdgcn_mfma_f32_16x16x32_bf16(a, b, aa, 0, 0, 0); }
                const int s = 16 * si + fr;
#pragma unroll
                for (int j = 0; j < 4; ++j) { const int t = 16 * ti + 4 * fq + j; const bool keep = dir ? (s >= t) : (s <= t);
                    AS[t * 40 + s] = f2bf(keep ? aa[j] : 0.f); } }
            LDS_BAR();
        }
        const bf16x8 vfrag = *(const LAS bf16x8*)(VT + tro(16 * wid + fr) + 8 * fq);
        if (OUT) {
#pragma unroll
            for (int ti = 0; ti < 2; ++ti) { const bf16x8 a = *(const LAS bf16x8*)(AS + (16 * ti + fr) * 40 + 8 * fq);
                ao[ti] = __builtin_amdgcn_mfma_f32_16x16x32_bf16(a, vfrag, ao[ti], 0, 0, 0); }
            float* sp = stash + ((size_t)(c * 2) * 512 + tid) * 4;
            if (!dir) { *(f32x4*)sp = ao[0]; *(f32x4*)(sp + 2048) = ao[1]; }
            else { const f32x4 s0 = *(const f32x4*)sp, s1 = *(const f32x4*)(sp + 2048);
#pragma unroll
                for (int j = 0; j < 4; ++j) { OT[(4 * fq + j) * 132 + 16 * wid + fr] = ao[0][j] + s0[j]; OT[(16 + 4 * fq + j) * 132 + 16 * wid + fr] = ao[1][j] + s1[j]; } }
        }
#pragma unroll
        for (int kt = 0; kt < 8; ++kt) { const f32x4 bl4 = *(const LAS f32x4*)(EL + 16 * kt + 4 * fq);
            const bf16x8 a = *(const LAS bf16x8*)(KT + tro(16 * kt + fr) + 8 * fq);
#pragma unroll
            for (int j = 0; j < 4; ++j) Sm[kt][j] *= bl4[j];
            Sm[kt] = __builtin_amdgcn_mfma_f32_16x16x32_bf16(a, vfrag, Sm[kt], 0, 0, 0); }
        if (!OUT && tid < 128) dsum += Bc[last * 128 + tid];
        LDS_BAR();
        if (OUT && dir) {
            const f32x4 o0 = *(const LAS f32x4*)(OT + t_ld * 132 + oc * 8), o1 = *(const LAS f32x4*)(OT + t_ld * 132 + oc * 8 + 4);
            float ss = 0.f;
#pragma unroll
            for (int e = 0; e < 4; ++e) ss += o0[e] * o0[e] + o1[e] * o1[e];
            ss += __shfl_xor(ss, 1); ss += __shfl_xor(ss, 2); ss += __shfl_xor(ss, 4); ss += __shfl_xor(ss, 8);
            const float rinv = rsqrtf(ss * (1.f / 128.f) + EPS);
            const f32x4 g0 = *(const f32x4*)(hp.gain + h * 128 + oc * 8), g1 = *(const f32x4*)(hp.gain + h * 128 + oc * 8 + 4);
            const f32x4 r0 = (f32x4){o0[0] * rinv * g0[0] * bflo(sg.x), o0[1] * rinv * g0[1] * bfhi(sg.x), o0[2] * rinv * g0[2] * bflo(sg.y), o0[3] * rinv * g0[3] * bfhi(sg.y)};
            const f32x4 r1 = (f32x4){o1[0] * rinv * g1[0] * bflo(sg.z), o1[1] * rinv * g1[1] * bfhi(sg.z), o1[2] * rinv * g1[2] * bflo(sg.w), o1[3] * rinv * g1[3] * bfhi(sg.w)};
            *(u32x4*)(hp.Pq + rowoff) = pack8(r0, r1);
        }
    }
}

__device__ __forceinline__ HgrnPtrs make_hp(const Params& p) {
    HgrnPtrs hp; unsigned char* R = p.ws + WS_R;
    hp.Pq = (bf16_t*)(R + R_PQ); hp.Plff = (const bf16_t*)(R + R_LFF); hp.Plfb = (const bf16_t*)(R + R_LFB); hp.Pv = (const bf16_t*)(R + R_PV); hp.Psg = (const bf16_t*)(R + R_SG);
    hp.gain = p.in[13]; return hp;
}

constexpr int A_LFF = 0, A_LFB = 16384, A_BF = 32768, A_BB = 49152, A_KTF = 65536, A_KTB = 76032, A_VT = 86528, A_ELF = 97024;
__device__ __forceinline__ void hgrn_phaseA(const Params& p, LAS unsigned char* lds) {
    const HgrnPtrs hp = make_hp(p);
    const int tid = threadIdx.x, wid = tid >> 6, lane = tid & 63, fr = lane & 15, fq = lane >> 4;
    const int t_ld = tid >> 4, oc = tid & 15;
    float* Sbuf = (float*)(p.ws + WS_S); float* Dbuf = (float*)(p.ws + WS_DB);
    LAS float* LFf = (LAS float*)(lds + A_LFF); LAS float* LFb = (LAS float*)(lds + A_LFB);
    LAS float* Bf = (LAS float*)(lds + A_BF); LAS float* Bb = (LAS float*)(lds + A_BB);
    LAS bf16_t* KTf = (LAS bf16_t*)(lds + A_KTF); LAS bf16_t* KTb = (LAS bf16_t*)(lds + A_KTB); LAS bf16_t* VT = (LAS bf16_t*)(lds + A_VT);
    LAS float* ELf = (LAS float*)(lds + A_ELF);
    for (int item = blockIdx.x; item < 512; item += gridDim.x) {
        const int b = item >> 6, seg = (item >> 2) & 15, h = item & 3, tokbase = T_CTX + b * 4096 + seg * 256;
        f32x4 Sf[8], Sb[8];
#pragma unroll
        for (int kt = 0; kt < 8; ++kt) { Sf[kt] = (f32x4){0.f, 0.f, 0.f, 0.f}; Sb[kt] = Sf[kt]; }
        float logP[8];
#pragma unroll
        for (int j = 0; j < 8; ++j) logP[j] = 0.f;
        float dsf = 0.f, dsb = 0.f;
        u32x4 lf_n, lb_n, vv_n;
        { const size_t ro = (size_t)(tokbase + t_ld) * 512 + h * 128 + oc * 8;
            lf_n = *(const u32x4*)(hp.Plff + ro); lb_n = *(const u32x4*)(hp.Plfb + ro); vv_n = *(const u32x4*)(hp.Pv + ro); }
#pragma unroll 1
        for (int c = 0; c < 8; ++c) {
            const u32x4 lvf = lf_n, lvb = lb_n, vv = vv_n;
            if (c < 7) { const size_t ro = (size_t)(tokbase + 32 * (c + 1) + t_ld) * 512 + h * 128 + oc * 8;
                lf_n = *(const u32x4*)(hp.Plff + ro); lb_n = *(const u32x4*)(hp.Plfb + ro); vv_n = *(const u32x4*)(hp.Pv + ro); }
            const float lff[8] = {bflo(lvf.x), bfhi(lvf.x), bflo(lvf.y), bfhi(lvf.y), bflo(lvf.z), bfhi(lvf.z), bflo(lvf.w), bfhi(lvf.w)};
            const float lfb[8] = {bflo(lvb.x), bfhi(lvb.x), bflo(lvb.y), bfhi(lvb.y), bflo(lvb.z), bfhi(lvb.z), bflo(lvb.w), bfhi(lvb.w)};
            *(LAS f32x4*)(LFf + t_ld * 128 + oc * 8) = (f32x4){lff[0], lff[1], lff[2], lff[3]}; *(LAS f32x4*)(LFf + t_ld * 128 + oc * 8 + 4) = (f32x4){lff[4], lff[5], lff[6], lff[7]};
            *(LAS f32x4*)(LFb + t_ld * 128 + oc * 8) = (f32x4){lfb[0], lfb[1], lfb[2], lfb[3]}; *(LAS f32x4*)(LFb + t_ld * 128 + oc * 8 + 4) = (f32x4){lfb[4], lfb[5], lfb[6], lfb[7]};
            { LAS bf16_t* d = VT + tro(oc * 8) + t_ld;
                d[0] = (bf16_t)(vv.x & 0xffffu); d[40] = (bf16_t)(vv.x >> 16); d[80] = (bf16_t)(vv.y & 0xffffu); d[120] = (bf16_t)(vv.y >> 16);
                d[160] = (bf16_t)(vv.z & 0xffffu); d[200] = (bf16_t)(vv.z >> 16); d[240] = (bf16_t)(vv.w & 0xffffu); d[280] = (bf16_t)(vv.w >> 16); }
            LDS_BAR();
            {
                const int k = tid & 127, part = (tid >> 7) & 1; const bool isb = tid >= 256;
                LAS float* src = isb ? LFb : LFf; LAS float* dst = isb ? Bb : Bf; float pre = 0.f;
                for (int t = 0; t < 16 * part; ++t) pre += src[t * 128 + k];
#pragma unroll
                for (int e = 0; e < 16; ++e) { const int t = 16 * part + e; pre += src[t * 128 + k]; dst[t * 128 + k] = pre; }
                if (!isb && part == 1) ELf[k] = __expf(pre);
            }
            LDS_BAR();
            {
                const f32x4 bf0 = *(const LAS f32x4*)(Bf + t_ld * 128 + oc * 8), bf1 = *(const LAS f32x4*)(Bf + t_ld * 128 + oc * 8 + 4);
                const f32x4 lf0 = *(const LAS f32x4*)(Bf + 31 * 128 + oc * 8), lf1 = *(const LAS f32x4*)(Bf + 31 * 128 + oc * 8 + 4);
                const f32x4 bb0 = *(const LAS f32x4*)(Bb + t_ld * 128 + oc * 8), bb1 = *(const LAS f32x4*)(Bb + t_ld * 128 + oc * 8 + 4);
                const f32x4 tb0 = *(const LAS f32x4*)(Bb + 31 * 128 + oc * 8), tb1 = *(const LAS f32x4*)(Bb + 31 * 128 + oc * 8 + 4);
                LAS bf16_t* df = KTf + tro(oc * 8) + t_ld; LAS bf16_t* db = KTb + tro(oc * 8) + t_ld;
#pragma unroll
                for (int j = 0; j < 8; ++j) { const float bfv = j < 4 ? bf0[j & 3] : bf1[j & 3], blf = j < 4 ? lf0[j & 3] : lf1[j & 3];
                    const float bbv = j < 4 ? bb0[j & 3] : bb1[j & 3], tb = j < 4 ? tb0[j & 3] : tb1[j & 3];
                    const float kf = (1.f - __expf(lff[j])) * __expf(blf - bfv);
                    const float kb = (1.f - __expf(lfb[j])) * __expf(logP[j] + bbv - lfb[j]);
                    df[j * 40] = f2bf(kf); db[j * 40] = f2bf(kb);
                    logP[j] += tb; }
            }
            if (tid < 128) { dsf += Bf[31 * 128 + tid]; dsb += Bb[31 * 128 + tid]; }
            LDS_BAR();
            const bf16x8 vfrag = *(const LAS bf16x8*)(VT + tro(16 * wid + fr) + 8 * fq);
#pragma unroll
            for (int kt = 0; kt < 8; ++kt) { const f32x4 e4 = *(const LAS f32x4*)(ELf + 16 * kt + 4 * fq);
                const bf16x8 af = *(const LAS bf16x8*)(KTf + tro(16 * kt + fr) + 8 * fq);
                const bf16x8 ab = *(const LAS bf16x8*)(KTb + tro(16 * kt + fr) + 8 * fq);
#pragma unroll
                for (int j = 0; j < 4; ++j) Sf[kt][j] *= e4[j];
                Sf[kt] = __builtin_amdgcn_mfma_f32_16x16x32_bf16(af, vfrag, Sf[kt], 0, 0, 0);
                Sb[kt] = __builtin_amdgcn_mfma_f32_16x16x32_bf16(ab, vfrag, Sb[kt], 0, 0, 0); }
            LDS_BAR();
        }
#pragma unroll 1
        for (int dir = 0; dir < 2; ++dir) {
            const size_t ci = (size_t)(((b * 4 + h) * 2 + dir) * 16 + seg);
            float* sp = Sbuf + ci * 16384;
#pragma unroll
            for (int kt = 0; kt < 8; ++kt)
#pragma unroll
                for (int j = 0; j < 4; ++j) sp[(16 * kt + 4 * fq + j) * 128 + 16 * wid + fr] = dir ? Sb[kt][j] : Sf[kt][j];
            if (tid < 128) Dbuf[ci * 128 + tid] = __expf(dir ? dsb : dsf);
        }
    }
}
__device__ __forceinline__ void hgrn_phaseB(const Params& p) {
    float* Sbuf = (float*)(p.ws + WS_S); const float* Dbuf = (const float*)(p.ws + WS_DB); const float* st = p.in[2];
    for (int idx = blockIdx.x * 512 + threadIdx.x; idx < 64 * 4096; idx += gridDim.x * 512) {
        const int chain = idx >> 12, e = idx & 4095, k = e >> 5, v4 = e & 31;
        const int b = chain >> 3, h = (chain >> 1) & 3, dir = chain & 1;
        f32x4 S = *(const f32x4*)(st + ((size_t)((b * 2 + dir) * 4 + h) * 128 + k) * 128 + 4 * v4);
        f32x4 L[16]; float dd[16];
#pragma unroll
        for (int i = 0; i < 16; ++i) { const int seg = dir ? 15 - i : i;
            L[i] = *(const f32x4*)(Sbuf + ((size_t)chain * 16 + seg) * 16384 + k * 128 + 4 * v4); dd[i] = Dbuf[((size_t)chain * 16 + seg) * 128 + k]; }
#pragma unroll
        for (int i = 0; i < 16; ++i) { const int seg = dir ? 15 - i : i;
            *(f32x4*)(Sbuf + ((size_t)chain * 16 + seg) * 16384 + k * 128 + 4 * v4) = S;
#pragma unroll
            for (int e2 = 0; e2 < 4; ++e2) S[e2] = dd[i] * S[e2] + L[i][e2]; }
    }
}
__device__ __forceinline__ void hgrn_phaseC(const Params& p, LAS unsigned char* lds) {
    const HgrnPtrs hp = make_hp(p);
    const int tid = threadIdx.x, wid = tid >> 6, lane = tid & 63, fr = lane & 15, fq = lane >> 4;
    const float* Sbuf = (const float*)(p.ws + WS_S);
    float* stash = (float*)(p.ws + WS_STASH) + (size_t)blockIdx.x * 32768;
    float* ostate = p.out + (size_t)T_ALL * 1024;
    for (int item = blockIdx.x; item < 640; item += gridDim.x) {
        const bool lat = item < 512;
        int b, seg = 0, h, tokbase;
        if (lat) { b = item >> 6; seg = (item >> 2) & 15; h = item & 3; tokbase = T_CTX + b * 4096 + seg * 256; }
        else { const int i2 = item - 512; b = i2 >> 2; h = i2 & 3; tokbase = b * 256; }
#pragma unroll 1
        for (int dir = 0; dir < 2; ++dir) {
            f32x4 Sm[8];
            if (lat) { const float* sp = Sbuf + (size_t)(((b * 4 + h) * 2 + dir) * 16 + seg) * 16384;
#pragma unroll
                for (int kt = 0; kt < 8; ++kt)
#pragma unroll
                    for (int j = 0; j < 4; ++j) Sm[kt][j] = sp[(16 * kt + 4 * fq + j) * 128 + 16 * wid + fr]; }
            else {
#pragma unroll
                for (int kt = 0; kt < 8; ++kt) Sm[kt] = (f32x4){0.f, 0.f, 0.f, 0.f}; }
            float dsum = 0.f;
            hgrn_pass<true>(lds, hp, tokbase, h, dir, Sm, stash, dsum);
            if (!lat) { float* sp = ostate + (size_t)((b * 2 + dir) * 4 + h) * 16384;
#pragma unroll
                for (int kt = 0; kt < 8; ++kt)
#pragma unroll
                    for (int j = 0; j < 4; ++j) sp[(16 * kt + 4 * fq + j) * 128 + 16 * wid + fr] = Sm[kt][j]; }
        }
    }
}


template <int PHN>
__device__ __forceinline__ void run_phase(const Params& p, LAS unsigned char* lds) {
    unsigned char* ws = p.ws;
    bf16_t* HF = (bf16_t*)(ws + WS_HF);
    bf16_t* ACT = (bf16_t*)(ws + WS_R);
    bf16_t* PZ = (bf16_t*)(ws + WS_R + R_PZ);
    bf16_t* PQ = (bf16_t*)(ws + WS_R + R_PQ);
    bf16_t* GA = (bf16_t*)(ws + WS_R + R_GA);
    bf16_t* GB = (bf16_t*)(ws + WS_R + R_GB);
    if constexpr (PHN == 0) phase0(p, lds);
    else if constexpr (PHN == 1) seam_phase<0>(p);
    else if constexpr (PHN == 2) { EpiSwiglu E; E.O = ACT; run_gemm(lds, HF, (const bf16_t*)(ws + WS_WIN0), 5632, 1024, E); }
    else if constexpr (PHN == 3) { EpiPlain E; E.O = HF; E.ldc = 1024; E.O1 = (bf16_t*)(ws + WS_S); run_gemm(lds, ACT, (const bf16_t*)(ws + WS_WOUT0), 1024, DFF, E, FFN_KSPLIT, DFF, DFF);
        const int nb = (int)gridDim.x, rem = 640 % nb; int first = (int)blockIdx.x, stride = nb;
        if (rem != 0) { first = (int)blockIdx.x - rem; stride = nb - rem; }
        if (first >= 0) { __syncthreads(); conv_tiles<false>(p, lds, first, stride); }
    }
    else if constexpr (PHN == 4) seam_phase<1>(p);
    else if constexpr (PHN == 5) { EpiMixA E; E.PZ = PZ; E.Pq = PQ; E.Plff = (bf16_t*)(ws + WS_R + R_LFF); E.Plfb = (bf16_t*)(ws + WS_R + R_LFB); E.Pv = (bf16_t*)(ws + WS_R + R_PV); E.Psg = (bf16_t*)(ws + WS_R + R_SG);
        E.lb = (const float*)(ws + WS_LB); run_gemm(lds, HF, (const bf16_t*)(ws + WS_WMIXA), 3584, 1024, E); }
    else if constexpr (PHN == 6) {
        hgrn_phaseA(p, lds);
        for (int it = blockIdx.x; it < 256; it += gridDim.x) { const int b = it >> 3, g = (it >> 1) & 3, slab = it & 1;
            fourier_item<64, 256, 256, 0>(lds, PZ, b * 256, 1, g * 256 + slab * 64, (const bf16_t*)(ws + WS_TTC)); }
        for (int it = blockIdx.x; it < 2048; it += gridDim.x) { const int b = it >> 8, r = (it >> 2) & 63, g = it & 3;
            fourier_item<128, 64, 128, 1>(lds, PZ, T_CTX + b * 4096 + r * 64, 1, g * 256, (const bf16_t*)(ws + WS_TT2)); }
    }
    else if constexpr (PHN == 7) hgrn_phaseB(p);
    else if constexpr (PHN == 8) {
        hgrn_phaseC(p, lds);
        const int nb = (int)gridDim.x, rem = 640 % nb;
        int first = 0, stride = nb;
        if (rem != 0) { first = rem; stride = nb - rem; }
        if ((int)blockIdx.x >= first) {
            __syncthreads();
            for (int it = (int)blockIdx.x - first; it < 2048; it += stride) { const int b = it >> 8, c = (it >> 2) & 63, g = it & 3;
                fourier_item<128, 64, 64, 2>(lds, PZ, T_CTX + b * 4096 + c, 64, g * 256, (const bf16_t*)(ws + WS_TT3)); }
        }
    }
    else if constexpr (PHN == 9) {
        { EpiPlain E; E.O = GA; E.ldc = 1024; run_gemm(lds, PZ, (const bf16_t*)(ws + WS_WFOUR), 1024, 512, E, 1, 1024, 512, 512); }
        { EpiPlain E; E.O = GB; E.ldc = 1024; run_gemm(lds, PQ, (const bf16_t*)(ws + WS_WHGRN), 1024, 512, E); }
    }
    else if constexpr (PHN == 10) { EpiGateMerge E; E.BA = GA; E.BB = GB; E.O = PZ; run_gemm(lds, HF, (const bf16_t*)(ws + WS_WGATE), 2048, 1024, E); }
    else if constexpr (PHN == 11) { EpiPlain E; E.O = HF; E.ldc = 1024; run_gemm(lds, PZ, (const bf16_t*)(ws + WS_WO), 1024, 1024, E); }
    else if constexpr (PHN == 12) seam_phase<2>(p);
    else if constexpr (PHN == 13) { EpiSwiglu E; E.O = ACT; run_gemm(lds, HF, (const bf16_t*)(ws + WS_WIN1), 5632, 1024, E); }
    else if constexpr (PHN == 14) { EpiPlain E; E.O = HF; E.ldc = 1024; E.O1 = (bf16_t*)(ws + WS_S); run_gemm(lds, ACT, (const bf16_t*)(ws + WS_WOUT1), 1024, DFF, E, FFN_KSPLIT, DFF, DFF); }
    else seam_phase<3>(p);
}
template <int... Ns> struct PhaseList {};
template <bool FIRST, int N0, int... Ns>
__device__ __forceinline__ void run_all(const Params& p, LAS unsigned char* lds, cg::grid_group& grid, XcdBarrier& xb, PhaseList<N0, Ns...>) {
    run_phase<N0>(p, lds);
    if constexpr (sizeof...(Ns) > 0) {
        if constexpr (FIRST) { grid.sync(); xb = xcd_barrier_post((unsigned*)(p.ws + WS_BAR), xb.st); }
        else xcd_barrier(xb);
        run_all<false>(p, lds, grid, xb, PhaseList<Ns...>{}); }
}
#ifndef SCHED_LIST
#define SCHED_LIST 0, 1, 2, 3, 4, 5, 6, 7, 8, 9, 10, 11, 12, 13, 14, 15
#endif
typedef PhaseList<SCHED_LIST> Sched;

__global__ void __launch_bounds__(512, 2) mk_forward(Params p) {
    extern __shared__ __attribute__((aligned(16))) unsigned char lds_raw[];
    LAS unsigned char* lds = (LAS unsigned char*)lds_raw;
    cg::grid_group grid = cg::this_grid();
    volatile LAS unsigned* st = (volatile LAS unsigned*)(lds + LDS_PHASE_BYTES);
    if (threadIdx.x == 0) { st[0] = 0u; st[1] = 0u; }
    __syncthreads();
    if (blockIdx.x == 0) { unsigned* bar = (unsigned*)(p.ws + WS_BAR); for (int i = threadIdx.x; i < XCD_BAR_WORDS; i += 512) bar[i] = 0u; }
    XcdBarrier xb; xb.bar = nullptr; xb.x = 0u; xb.st = st;
    run_all<true>(p, lds, grid, xb, Sched{});
}

extern "C" void kernel_launch(void* const* d_in, const int* in_sizes, int n_in, void* d_out, int out_size, void* d_ws, size_t ws_size, hipStream_t stream) {
    static int grid = 0;
    if (grid == 0) {
        if (n_in != 17 || ws_size < WS_END) { fprintf(stderr, "kernel_launch: need 17 inputs and >= %zu bytes of workspace; got %d, %zu\n", (size_t)WS_END, n_in, ws_size); grid = -1; return; }
        int dev = 0, cus = 0, per_cu = 0;
        if (hipGetDevice(&dev) != hipSuccess || hipDeviceGetAttribute(&cus, hipDeviceAttributeMultiprocessorCount, dev) != hipSuccess) { grid = -1; return; }
        if (hipFuncSetAttribute((const void*)mk_forward, hipFuncAttributeMaxDynamicSharedMemorySize, LDS_BYTES) != hipSuccess) { fprintf(stderr, "kernel_launch: hipFuncSetAttribute failed\n"); grid = -1; return; }
        if (hipOccupancyMaxActiveBlocksPerMultiprocessor(&per_cu, (const void*)mk_forward, 512, LDS_BYTES) != hipSuccess || per_cu < 1) { fprintf(stderr, "kernel_launch: occupancy query failed (%d)\n", per_cu); grid = -1; return; }
        grid = cus * per_cu; if (grid > 256) grid = 256;
    }
    if (grid < 0) return;
    Params p{};
    for (int i = 0; i < 17; ++i) p.in[i] = (const float*)d_in[i];
    p.out = (float*)d_out; p.ws = (unsigned char*)d_ws;
    void* args[] = {&p};
    hipError_t e = hipLaunchCooperativeKernel((const void*)mk_forward, dim3(grid), dim3(512), args, LDS_BYTES, stream);
    if (e != hipSuccess) fprintf(stderr, "cooperative launch failed: %s (grid %d)\n", hipGetErrorString(e), grid);
}
```
